# Optimizing an MI355X kernel written in HIP

```python
import jax, jax.numpy as jnp
from jax import lax
import numpy as np

D_MODEL = 2048
BATCH = 1
SEQ = 8192
DEPTH = 2

MEM_LEN = 256
N_MIXERS = 2
D_FF = 5632
CHUNK = 128
GMLP_WIDTH = 2048
GMLP_GROUPS = 8
GMLP_GROUP_DIM = GMLP_WIDTH // GMLP_GROUPS
CONV_WIDTH = 3
XATTN_HEADS = 4
XATTN_HEAD_DIM = D_MODEL // XATTN_HEADS
RMS_EPS = 1e-6
LN_EPS = 1e-5

kernel_name = "hybrid_gmlp_shortconv_macaron_memxattn"


def rmsnorm(x, g):
    xf = x.astype(jnp.float32)
    y = xf * lax.rsqrt(jnp.mean(xf * xf, axis=-1, keepdims=True) + RMS_EPS)
    return (y * g.astype(jnp.float32)).astype(x.dtype)


def layernorm(x, g, b):
    xf = x.astype(jnp.float32)
    mu = jnp.mean(xf, axis=-1, keepdims=True)
    xc = xf - mu
    var = jnp.mean(xc * xc, axis=-1, keepdims=True)
    y = xc * lax.rsqrt(var + LN_EPS) * g.astype(jnp.float32) + b.astype(jnp.float32)
    return y.astype(x.dtype)


def swiglu(h, w13, w2):
    gate, up = jnp.split(h @ w13, 2, axis=-1)
    return (jax.nn.silu(gate) * up) @ w2


def gmlp_mixer(h, w_in, ln_g, ln_b, w_s, b_s, w_out):
    bsz, seq, _ = h.shape
    z = jax.nn.gelu(h @ w_in, approximate=False)
    u, v = jnp.split(z, 2, axis=-1)
    v = layernorm(v, ln_g, ln_b)
    vc = v.reshape(bsz, seq // CHUNK, CHUNK, GMLP_GROUPS, GMLP_GROUP_DIM)
    causal = jnp.tril(jnp.ones((CHUNK, CHUNK), dtype=bool))
    w = jnp.where(causal[None], w_s, jnp.zeros_like(w_s)).astype(vc.dtype)
    f = jnp.einsum('gts,bcsge->bctge', w, vc) + b_s.T[:, :, None].astype(vc.dtype)
    return (u * f.reshape(bsz, seq, GMLP_WIDTH)) @ w_out


def short_conv_mixer(h, w_in, conv_w, w_out):
    d = h.shape[-1]
    gate_b, gate_c, val = jnp.split(h @ w_in, 3, axis=-1)
    z = gate_c * val
    kern = conv_w[:, None, :].astype(z.dtype)
    conv = lax.conv_general_dilated(
        z, kern, window_strides=(1,), padding=[(CONV_WIDTH - 1, 0)],
        dimension_numbers=('NWC', 'WIO', 'NWC'), feature_group_count=d)
    return (gate_b * conv) @ w_out


def mem_cross_attn(h, mem_n, wq, wkv, wo):
    bsz, seq, d = h.shape
    m = mem_n.shape[1]
    q = (h @ wq).reshape(bsz, seq, XATTN_HEADS, XATTN_HEAD_DIM)
    k, v = jnp.split(mem_n @ wkv, 2, axis=-1)
    k = k.reshape(bsz, m, XATTN_HEADS, XATTN_HEAD_DIM)
    v = v.reshape(bsz, m, XATTN_HEADS, XATTN_HEAD_DIM)
    s = jnp.einsum('bshd,bmhd->bhsm', q, k).astype(jnp.float32) * (XATTN_HEAD_DIM ** -0.5)
    p = jax.nn.softmax(s, axis=-1).astype(v.dtype)
    o = jnp.einsum('bhsm,bmhd->bshd', p, v).reshape(bsz, seq, d)
    return o @ wo


def setup_inputs(seed: int = 0) -> dict:
    key = jax.random.key(seed)
    ks = iter(jax.random.split(key, 32))
    n_a = (DEPTH + 1) // 2
    n_b = DEPTH // 2
    D, F, E = D_MODEL, D_FF, GMLP_WIDTH

    def w(shape, fan_in):
        return jax.random.normal(next(ks), shape, jnp.float32) * (fan_in ** -0.5)

    def gain(shape):
        return 1.0 + 0.02 * jax.random.normal(next(ks), shape, jnp.float32)

    def bias(shape):
        return 0.02 * jax.random.normal(next(ks), shape, jnp.float32)

    return {
        "x": jax.random.normal(next(ks), (BATCH, SEQ, D), jnp.float32),
        "mem": jax.random.normal(next(ks), (BATCH, MEM_LEN, D), jnp.float32),
        "ffn1_norm": gain((DEPTH, D)),
        "ffn1_w13": w((DEPTH, D, 2 * F), D),
        "ffn1_w2": w((DEPTH, F, D), F),
        "mix_norm": gain((DEPTH, D)),
        "gmlp_w_in": w((n_a, D, 2 * E), D),
        "gmlp_ln_g": gain((n_a, E)),
        "gmlp_ln_b": bias((n_a, E)),
        "gmlp_w_s": w((n_a, GMLP_GROUPS, CHUNK, CHUNK), CHUNK),
        "gmlp_b_s": gain((n_a, GMLP_GROUPS, CHUNK)),
        "gmlp_w_out": w((n_a, E, D), E),
        "conv_w_in": w((n_b, D, 3 * D), D),
        "conv_w": w((n_b, CONV_WIDTH, D), CONV_WIDTH),
        "conv_w_out": w((n_b, D, D), D),
        "xattn_norm": gain((DEPTH, D)),
        "mem_norm": gain((DEPTH, D)),
        "xattn_wq": w((DEPTH, D, D), D),
        "xattn_wkv": w((DEPTH, D, 2 * D), D),
        "xattn_wo": w((DEPTH, D, D), D),
        "ffn2_norm": gain((DEPTH, D)),
        "ffn2_w13": w((DEPTH, D, 2 * F), D),
        "ffn2_w2": w((DEPTH, F, D), F),
        "final_norm": gain((D,)),
    }


def reference(x, mem, ffn1_norm, ffn1_w13, ffn1_w2, mix_norm,
              gmlp_w_in, gmlp_ln_g, gmlp_ln_b, gmlp_w_s, gmlp_b_s, gmlp_w_out,
              conv_w_in, conv_w, conv_w_out,
              xattn_norm, mem_norm, xattn_wq, xattn_wkv, xattn_wo,
              ffn2_norm, ffn2_w13, ffn2_w2, final_norm):
    for i in range(DEPTH):
        x = x + 0.5 * swiglu(rmsnorm(x, ffn1_norm[i]), ffn1_w13[i], ffn1_w2[i])
        h = rmsnorm(x, mix_norm[i])
        j = i // N_MIXERS
        if i % N_MIXERS == 0:
            x = x + gmlp_mixer(h, gmlp_w_in[j], gmlp_ln_g[j], gmlp_ln_b[j],
                               gmlp_w_s[j], gmlp_b_s[j], gmlp_w_out[j])
        else:
            x = x + short_conv_mixer(h, conv_w_in[j], conv_w[j], conv_w_out[j])
        x = x + mem_cross_attn(rmsnorm(x, xattn_norm[i]), rmsnorm(mem, mem_norm[i]),
                               xattn_wq[i], xattn_wkv[i], xattn_wo[i])
        x = x + 0.5 * swiglu(rmsnorm(x, ffn2_norm[i]), ffn2_w13[i], ffn2_w2[i])
    return rmsnorm(x, final_norm)
```

```cpp
#include <hip/hip_runtime.h>
#include <hip/hip_cooperative_groups.h>
#include <cstdio>
#include <cstdint>
namespace cg = cooperative_groups;

#ifndef PROBE_DUP
#define PROBE_DUP 0
#endif
#ifndef MK_PER_PHASE
#define MK_PER_PHASE 0
#endif

constexpr int M = 8192, D = 2048, FF = 5632, MEM = 256, NH = 4, HD = 512, GW = 2048, NG = 8, CH = 128;
constexpr float RMS_EPS = 1e-6f, LN_EPS = 1e-5f;

#define LAS __attribute__((address_space(3)))
typedef unsigned short bf16_t;
typedef short bf16x8 __attribute__((ext_vector_type(8)));
typedef float f32x4 __attribute__((ext_vector_type(4)));
typedef float f32x2 __attribute__((ext_vector_type(2)));
typedef unsigned u32x4 __attribute__((ext_vector_type(4)));
typedef unsigned u32x2 __attribute__((ext_vector_type(2)));

constexpr size_t al(size_t x) { return (x + 4095) & ~(size_t)4095; }
constexpr size_t SZ_W13T = (size_t)2 * FF * D * 2, SZ_W2T = (size_t)D * FF * 2;
constexpr size_t WS_W13T = 0;
constexpr size_t WS_W2T = WS_W13T + 4 * SZ_W13T;
constexpr size_t WS_GWIN = WS_W2T + 4 * SZ_W2T;
constexpr size_t WS_GWOUT = WS_GWIN + (size_t)2 * GW * D * 2;
constexpr size_t WS_CWIN = WS_GWOUT + (size_t)D * GW * 2;
constexpr size_t WS_CWOUT = WS_CWIN + (size_t)3 * D * D * 2;
constexpr size_t WS_WQB = WS_CWOUT + (size_t)D * D * 2;
constexpr size_t WS_WKVT = WS_WQB + (size_t)2 * D * D * 2;
constexpr size_t WS_WOT = WS_WKVT + (size_t)2 * 2 * D * D * 2;
constexpr size_t WS_WQKT = WS_WOT + (size_t)2 * D * D * 2;
constexpr size_t WS_VWOT = WS_WQKT + (size_t)2 * 1024 * D * 2;
constexpr size_t WS_WSB = WS_VWOT + (size_t)2 * D * 1024 * 2;
constexpr size_t WS_MEMN = WS_WSB + (size_t)NG * CH * CH * 2;
constexpr size_t WS_KV = WS_MEMN + (size_t)2 * MEM * D * 2;
constexpr size_t WS_XB = WS_KV + (size_t)2 * MEM * 2 * D * 2;
constexpr size_t WS_H = WS_XB + (size_t)M * D * 2;
constexpr size_t WS_U = WS_H + (size_t)M * FF * 2;
constexpr size_t WS_V = WS_U + (size_t)M * D * 2;
constexpr size_t WS_Y = WS_V + (size_t)M * D * 2;
constexpr size_t WS_P = WS_Y + (size_t)M * D * 2;
constexpr size_t WS_PART = WS_P + (size_t)M * 1024 * 2;
constexpr size_t WS_LNP = WS_PART + (size_t)M * 32 * 4;
constexpr size_t WS_BAR = WS_LNP + (size_t)M * 64 * 4;
constexpr size_t WS_XT = WS_BAR + 16384;
constexpr size_t WS_END = WS_XT + (size_t)M * D * 4;

constexpr int LDS_MISC = 131072 + 8192, LDS_BYTES = LDS_MISC + 256;

__device__ __forceinline__ size_t tm_off(int r, int k, int K) { return ((size_t)((r >> 8) * (K >> 6) + (k >> 6)) << 14) + (size_t)(((((k >> 5) & 1) << 8) + (r & 255)) << 5) + (k & 31); }

namespace pg8 {
constexpr int BM = 256, BK = 64, HALF = 128, HTB = HALF * BK * 2, STAGE_BYTES = 8 * HTB, NXCD = 8, WGM = 8;
__host__ __device__ __forceinline__ int lds_byte(int r, int c) { const int st = (r >> 4) * 2 + (c >> 5), rr = r & 15, cc = c & 31, ob = rr * 64 + cc * 2; return st * 1024 + (ob ^ (((ob >> 9) & 1) << 5)); }
__host__ __device__ __forceinline__ void stage_rc(int b, int& R, int& C) { const int st = b / 1024, sb = b % 1024, swz = sb ^ (((sb >> 9) & 1) << 5); R = (st >> 1) * 16 + swz / 64; C = (st & 1) * 32 + (swz % 64) / 2; }
__host__ __device__ __forceinline__ int perm32(int rho) { const int n = rho >> 4, i = rho & 15; return 8 * (i >> 2) + 4 * n + (i & 3); }

struct Unit { int pm, pn, z; };
struct Gemm { const bf16_t* A; const bf16_t* Bt; int lda, ldb, K, nM, nN, nZ; long sAm, sAn, sAz, sBm, sBn, sBz; int btile, atile; };

struct StaticOrder {
    int nM, nN, nper, nwg, G, c;
    __device__ __forceinline__ void init(int nM_, int nN_, int nZ_, int G_, int c_) { nM = nM_; nN = nN_; nper = nM * nN; nwg = nper * nZ_; G = G_; c = c_; }
    __device__ __forceinline__ bool next(int i, Unit& u) const {
        const long L = (long)i * G + c; if (L >= nwg) return false;
        int wgid = (int)L; { const int q = nwg / NXCD, r = nwg % NXCD, xcd = wgid % NXCD, off = wgid / NXCD; wgid = (xcd < r ? xcd * (q + 1) : r * (q + 1) + (xcd - r) * q) + off; }
        u.z = wgid / nper; wgid -= u.z * nper;
        const int nig = WGM * nN, gid = wgid / nig, fm = gid * WGM, gsz = (nM - fm) < WGM ? (nM - fm) : WGM;
        u.pm = fm + ((wgid % nig) % gsz); u.pn = (wgid % nig) / gsz; return true;
    }
};

__device__ __forceinline__ unsigned cvt_pk_bf16(float lo, float hi) { unsigned r; asm volatile("v_cvt_pk_bf16_f32 %0, %1, %2" : "=v"(r) : "v"(lo), "v"(hi)); return r; }
__device__ __forceinline__ f32x2 gelu_pk(f32x2 v) {
    const f32x2 av = __builtin_elementwise_abs(v), d = av * 0.2316418882f + 1.0f;
    f32x2 t; t.x = __builtin_amdgcn_rcpf(d.x); t.y = __builtin_amdgcn_rcpf(d.y);
    f32x2 q = t * 0.5307027145f + (-0.7265760135f); q = q * t + 0.7107068705f; q = q * t + (-0.142248368f); q = q * t + 0.127414796f; q = q * t;
    const f32x2 s = (v * v) * (-0.72134752044f);
    f32x2 e; e.x = __builtin_amdgcn_exp2f(s.x); e.y = __builtin_amdgcn_exp2f(s.y);
    const f32x2 m = v * (q * e), r = v - m;
    f32x2 o; o.x = v.x < 0.f ? m.x : r.x; o.y = v.y < 0.f ? m.y : r.y; return o;
}
__device__ __forceinline__ f32x4 gelu4(f32x4 v) { const f32x2 a = gelu_pk((f32x2){v[0], v[1]}), b = gelu_pk((f32x2){v[2], v[3]}); return (f32x4){a.x, a.y, b.x, b.y}; }
__device__ __forceinline__ u32x4 pack8(f32x4 a, f32x4 b) { u32x4 w; w.x = cvt_pk_bf16(a[0], a[1]); w.y = cvt_pk_bf16(a[2], a[3]); w.z = cvt_pk_bf16(b[0], b[1]); w.w = cvt_pk_bf16(b[2], b[3]); return w; }
__device__ __forceinline__ float row_rstd(const float* part, int r) {
    const f32x4* p = (const f32x4*)(part + (size_t)r * 32);
    f32x4 s = p[0];
#pragma unroll
    for (int i = 1; i < 8; ++i) s += p[i];
    const float t = (s[0] + s[1]) + (s[2] + s[3]);
    return 1.0f / sqrtf(t * (1.0f / D) + RMS_EPS);
}
__device__ __forceinline__ float tile_rstd(const LAS float* rst, int ui, int rl, const float* part, int r) { return ui < 8 ? rst[ui * 256 + rl] : row_rstd(part, r); }
__device__ __forceinline__ float silu1(float g) { return g * __builtin_amdgcn_rcpf(1.0f + __builtin_amdgcn_exp2f(g * -1.44269504089f)); }

struct EpiBf16 {
    static constexpr bool PERM = true, AFTER_DRAIN = false, NEEDS_RS = false, ACC_INIT = false;
    bf16_t* C; int ldc; long sCz; float scale; const float* part;
    __device__ __forceinline__ void operator()(const f32x4 (&acc)[2][2][4][2], const Unit& u, int ui, const LAS float* rst, int wr, int wc, int fr, int fq) const {
        bf16_t* base = C + (size_t)u.z * sCz + (size_t)(u.pm * BM + wr * 64 + fr) * ldc + u.pn * BM + wc * 32 + 8 * fq;
#pragma unroll
        for (int ai = 0; ai < 2; ++ai)
#pragma unroll
            for (int m = 0; m < 4; ++m)
#pragma unroll
                for (int bj = 0; bj < 2; ++bj)
                    *(u32x4*)(base + (size_t)(ai * HALF + m * 16) * ldc + bj * HALF) = pack8(acc[ai][bj][m][0] * scale, acc[ai][bj][m][1] * scale);
    }
};
struct EpiSwiglu {
    static constexpr bool PERM = true, AFTER_DRAIN = false, NEEDS_RS = true, ACC_INIT = false;
    bf16_t* H; const float* part;
    __device__ __forceinline__ void operator()(const f32x4 (&acc)[2][2][4][2], const Unit& u, int ui, const LAS float* rst, int wr, int wc, int fr, int fq) const {
        const int row0 = u.pm * BM + wr * 64 + fr, col0 = u.pn * HALF + wc * 32 + 8 * fq;
#pragma unroll
        for (int ai = 0; ai < 2; ++ai)
#pragma unroll
            for (int m = 0; m < 4; ++m) {
                const int r = row0 + ai * HALF + m * 16; const float rs = tile_rstd(rst, ui, r - u.pm * BM, part, r), c2 = rs * -1.44269504089f, rs2 = rs * rs;
                f32x4 h[2];
#pragma unroll
                for (int n = 0; n < 2; ++n) {
                    const f32x4 g = acc[ai][0][m][n], t = g * c2;
                    const f32x4 d = (f32x4){__builtin_amdgcn_exp2f(t[0]), __builtin_amdgcn_exp2f(t[1]), __builtin_amdgcn_exp2f(t[2]), __builtin_amdgcn_exp2f(t[3])} + 1.0f;
                    const f32x4 r = (f32x4){__builtin_amdgcn_rcpf(d[0]), __builtin_amdgcn_rcpf(d[1]), __builtin_amdgcn_rcpf(d[2]), __builtin_amdgcn_rcpf(d[3])};
                    h[n] = ((g * acc[ai][1][m][n]) * r) * rs2; }
                *(u32x4*)(H + tm_off(r, col0, FF)) = pack8(h[0], h[1]);
            }
    }
};
struct EpiResid {
    static constexpr bool PERM = true, AFTER_DRAIN = false, NEEDS_RS = false, ACC_INIT = true;
    const float* base_rm; bf16_t* xb; float* part; float alpha, ialpha;
    __device__ __forceinline__ void init(f32x4 (&acc)[2][2][4][2], const Unit& u, int wr, int wc, int fr, int fq) const {
        const int row0 = u.pm * BM + wr * 64 + fr, col0 = u.pn * BM + wc * 32 + 8 * fq;
#pragma unroll
        for (int ai = 0; ai < 2; ++ai)
#pragma unroll
            for (int m = 0; m < 4; ++m)
#pragma unroll
                for (int bj = 0; bj < 2; ++bj) { const u32x4 w = *(const u32x4*)(xb + tm_off(row0 + ai * HALF + m * 16, col0 + bj * HALF, D));
                    acc[ai][bj][m][0] = (f32x4){__uint_as_float(w.x << 16), __uint_as_float(w.x & 0xffff0000u), __uint_as_float(w.y << 16), __uint_as_float(w.y & 0xffff0000u)} * ialpha;
                    acc[ai][bj][m][1] = (f32x4){__uint_as_float(w.z << 16), __uint_as_float(w.z & 0xffff0000u), __uint_as_float(w.w << 16), __uint_as_float(w.w & 0xffff0000u)} * ialpha; }
    }
    __device__ __forceinline__ void operator()(const f32x4 (&acc)[2][2][4][2], const Unit& u, int ui, const LAS float* rst, int wr, int wc, int fr, int fq) const {
        const int row0 = u.pm * BM + wr * 64 + fr, col0 = u.pn * BM + wc * 32 + 8 * fq;
#pragma unroll
        for (int ai = 0; ai < 2; ++ai)
#pragma unroll
            for (int m = 0; m < 4; ++m) {
                const int r = row0 + ai * HALF + m * 16; float ss = 0.f;
#pragma unroll
                for (int bj = 0; bj < 2; ++bj) {
                    const f32x4 o0 = acc[ai][bj][m][0] * alpha, o1 = acc[ai][bj][m][1] * alpha;
                    *(u32x4*)(xb + tm_off(r, col0 + bj * HALF, D)) = pack8(o0, o1);
                    ss += ((o0[0] * o0[0] + o0[1] * o0[1]) + (o0[2] * o0[2] + o0[3] * o0[3])) + ((o1[0] * o1[0] + o1[1] * o1[1]) + (o1[2] * o1[2] + o1[3] * o1[3])); }
                ss += __shfl_xor(ss, 16); ss += __shfl_xor(ss, 32);
                if (fq == 0) part[(size_t)r * 32 + u.pn * 4 + wc] = ss;
            }
    }
};
struct EpiGeluUV {
    static constexpr bool PERM = true, AFTER_DRAIN = false, NEEDS_RS = true, ACC_INIT = false;
    bf16_t* U; bf16_t* V; const float* part; float* lnp;
    __device__ __forceinline__ void operator()(const f32x4 (&acc)[2][2][4][2], const Unit& u, int ui, const LAS float* rst, int wr, int wc, int fr, int fq) const {
        const bool isv = u.pn >= 8; bf16_t* dst = isv ? V : U;
        const int row0 = u.pm * BM + wr * 64 + fr, col0 = (u.pn & 7) * BM + wc * 32 + 8 * fq;
#pragma unroll
        for (int ai = 0; ai < 2; ++ai)
#pragma unroll
            for (int m = 0; m < 4; ++m) {
                const int r = row0 + ai * HALF + m * 16; const float rs = tile_rstd(rst, ui, r - u.pm * BM, part, r); float s1 = 0.f, s2 = 0.f;
#pragma unroll
                for (int bj = 0; bj < 2; ++bj) { const f32x4 a = gelu4(acc[ai][bj][m][0] * rs), b = gelu4(acc[ai][bj][m][1] * rs);
                    *(u32x4*)(dst + tm_off(r, col0 + bj * HALF, GW)) = pack8(a, b);
                    s1 += ((a[0] + a[1]) + (a[2] + a[3])) + ((b[0] + b[1]) + (b[2] + b[3]));
                    s2 += ((a[0] * a[0] + a[1] * a[1]) + (a[2] * a[2] + a[3] * a[3])) + ((b[0] * b[0] + b[1] * b[1]) + (b[2] * b[2] + b[3] * b[3])); }
                if (isv) { s1 += __shfl_xor(s1, 16); s1 += __shfl_xor(s1, 32); s2 += __shfl_xor(s2, 16); s2 += __shfl_xor(s2, 32);
                    if (fq == 0) *(f32x2*)(lnp + ((size_t)r * 32 + (u.pn - 8) * 4 + wc) * 2) = (f32x2){s1, s2}; }
            }
    }
};
struct EpiConvIn {
    static constexpr bool PERM = true, AFTER_DRAIN = false, NEEDS_RS = true, ACC_INIT = false;
    bf16_t* Bg; bf16_t* Z; const float* part;
    __device__ __forceinline__ void operator()(const f32x4 (&acc)[2][2][4][2], const Unit& u, int ui, const LAS float* rst, int wr, int wc, int fr, int fq) const {
        const int row0 = u.pm * BM + wr * 64 + fr;
#pragma unroll
        for (int ai = 0; ai < 2; ++ai)
#pragma unroll
            for (int m = 0; m < 4; ++m) {
                const int r = row0 + ai * HALF + m * 16; const float rs = tile_rstd(rst, ui, r - u.pm * BM, part, r);
                if (u.pn < 8) {
#pragma unroll
                    for (int bj = 0; bj < 2; ++bj) *(u32x4*)(Bg + tm_off(r, u.pn * BM + bj * HALF + wc * 32 + 8 * fq, D)) = pack8(acc[ai][bj][m][0] * rs, acc[ai][bj][m][1] * rs);
                } else {
                    const float r2 = rs * rs;
                    *(u32x4*)(Z + tm_off(r, (u.pn - 8) * HALF + wc * 32 + 8 * fq, D)) = pack8(acc[ai][0][m][0] * acc[ai][1][m][0] * r2, acc[ai][0][m][1] * acc[ai][1][m][1] * r2);
                }
            }
    }
};
struct EpiSoftmax {
    static constexpr bool PERM = true, AFTER_DRAIN = true, NEEDS_RS = true, ACC_INIT = false;
    bf16_t* P; const float* part;
    __device__ __forceinline__ void fused(f32x4 (&acc)[2][2][4][2], const Unit& u, int ui, const LAS float* rst, int wr, int wc, int fr, int fq, LAS unsigned char* lds, int wid, int lane) const {
        LAS float* red = (LAS float*)lds;
        float sm[2][4];
#pragma unroll
        for (int ai = 0; ai < 2; ++ai)
#pragma unroll
            for (int m = 0; m < 4; ++m) {
                const int rl = ai * HALF + wr * 64 + m * 16 + fr; const float rs = tile_rstd(rst, ui, rl, part, u.pm * BM + rl);
                float mx = -3.0e38f;
#pragma unroll
                for (int bj = 0; bj < 2; ++bj)
#pragma unroll
                    for (int n = 0; n < 2; ++n) { f32x4 v = acc[ai][bj][m][n] * rs; acc[ai][bj][m][n] = v; mx = fmaxf(mx, fmaxf(fmaxf(v[0], v[1]), fmaxf(v[2], v[3]))); }
                mx = fmaxf(mx, __shfl_xor(mx, 16)); mx = fmaxf(mx, __shfl_xor(mx, 32));
                if (fq == 0) red[rl * 4 + wc] = mx;
            }
        __syncthreads();
#pragma unroll
        for (int ai = 0; ai < 2; ++ai)
#pragma unroll
            for (int m = 0; m < 4; ++m) {
                const int rl = ai * HALF + wr * 64 + m * 16 + fr; const f32x4 q = *(const LAS f32x4*)(red + rl * 4);
                const float mx = fmaxf(fmaxf(q[0], q[1]), fmaxf(q[2], q[3])); float s = 0.f;
#pragma unroll
                for (int bj = 0; bj < 2; ++bj)
#pragma unroll
                    for (int n = 0; n < 2; ++n) { f32x4 v = (acc[ai][bj][m][n] - mx) * 1.44269504089f;
                        v = (f32x4){__builtin_amdgcn_exp2f(v[0]), __builtin_amdgcn_exp2f(v[1]), __builtin_amdgcn_exp2f(v[2]), __builtin_amdgcn_exp2f(v[3])};
                        acc[ai][bj][m][n] = v; s += (v[0] + v[1]) + (v[2] + v[3]); }
                s += __shfl_xor(s, 16); s += __shfl_xor(s, 32); sm[ai][m] = s;
            }
        __syncthreads();
#pragma unroll
        for (int ai = 0; ai < 2; ++ai)
#pragma unroll
            for (int m = 0; m < 4; ++m) { const int rl = ai * HALF + wr * 64 + m * 16 + fr; if (fq == 0) red[rl * 4 + wc] = sm[ai][m]; }
        __syncthreads();
#pragma unroll
        for (int ai = 0; ai < 2; ++ai)
#pragma unroll
            for (int m = 0; m < 4; ++m) {
                const int rl = ai * HALF + wr * 64 + m * 16 + fr; const f32x4 q = *(const LAS f32x4*)(red + rl * 4);
                const float inv = 1.0f / ((q[0] + q[1]) + (q[2] + q[3]));
#pragma unroll
                for (int bj = 0; bj < 2; ++bj)
                    *(u32x4*)(P + tm_off(u.pm * BM + rl, u.pn * BM + bj * HALF + wc * 32 + 8 * fq, 1024)) = pack8(acc[ai][bj][m][0] * inv, acc[ai][bj][m][1] * inv);
            }
        __syncthreads();
    }
};

template <class Epi, bool ALIGN_EPI>
__device__ __forceinline__ void gemm_phase(LAS unsigned char* lds, const Gemm g, const StaticOrder& S, const Epi& E) {
    const int tid = threadIdx.x, wid = __builtin_amdgcn_readfirstlane(tid >> 6), lane = tid & 63, wr = wid >> 2, wc = wid & 3, fr = lane & 15, fq = lane >> 4;
    const int nt = g.K / BK;
    unsigned voffA[2], voffB[2];
#pragma unroll
    for (int i = 0; i < 2; ++i) { int R, C; stage_rc(tid * 16 + i * 8192, R, C); const int Rb = Epi::PERM ? ((R & ~31) + perm32(R & 31)) : R;
        voffA[i] = g.atile ? (unsigned)((((C >> 5) * BM + R) * 32) + (C & 31)) * 2u : (unsigned)(R * g.lda + C) * 2u; voffB[i] = g.btile ? (unsigned)((((C >> 5) * BM + Rb) * 32) + (C & 31)) * 2u : (unsigned)(Rb * g.ldb + C) * 2u; }
    const size_t kstepA = g.atile ? (size_t)(BM * BK * 2) : (size_t)(BK * 2), kstepB = g.btile ? (size_t)(BM * BK * 2) : (size_t)(BK * 2);
    const size_t hA = g.atile ? (size_t)(HALF * 32 * 2) : (size_t)HALF * g.lda * 2, hB = g.btile ? (size_t)(HALF * 32 * 2) : (size_t)HALF * g.ldb * 2;
    const unsigned ldsw = (unsigned)wid * 1024u;
    const int aoff = lds_byte(wr * 64 + fr, fq * 8), boff = lds_byte(wc * 32 + fr, fq * 8);
#define PG8_SA(b, h) (((b) * 2 + (h)) * HTB)
#define PG8_SB(b, h) ((4 + (b) * 2 + (h)) * HTB)
#define PG8_STAGE(bufoff, gbase, voff) do { _Pragma("unroll") for (int _i = 0; _i < 2; ++_i) \
        __builtin_amdgcn_global_load_lds((const unsigned*)((const char*)(gbase) + (voff)[_i]), (LAS unsigned*)(lds + (bufoff) + ldsw + _i * 8192), 16, 0, 0); } while (0)
#define PG8_LDA(dst, b, h) do { _Pragma("unroll") for (int m = 0; m < 4; ++m) _Pragma("unroll") for (int k = 0; k < 2; ++k) dst[m][k] = *(const LAS bf16x8*)(lds + PG8_SA(b, h) + aoff + m * 2048 + k * 1024); } while (0)
#define PG8_LDB(dst, b, h) do { _Pragma("unroll") for (int n = 0; n < 2; ++n) _Pragma("unroll") for (int k = 0; k < 2; ++k) dst[n][k] = *(const LAS bf16x8*)(lds + PG8_SB(b, h) + boff + n * 2048 + k * 1024); } while (0)
#define PG8_MMA(ai, bj, At, Bt) do { __builtin_amdgcn_s_setprio(1); _Pragma("unroll") for (int m = 0; m < 4; ++m) _Pragma("unroll") for (int n = 0; n < 2; ++n) _Pragma("unroll") for (int k = 0; k < 2; ++k) \
        acc[ai][bj][m][n] = __builtin_amdgcn_mfma_f32_16x16x32_bf16(Bt[n][k], At[m][k], acc[ai][bj][m][n], 0, 0, 0); __builtin_amdgcn_s_setprio(0); } while (0)
#define PG8_WAIT_V(n) asm volatile("s_waitcnt vmcnt(" #n ")" ::: "memory")
#define PG8_WAIT_L(n) asm volatile("s_waitcnt lgkmcnt(" #n ")" ::: "memory")
#define PG8_BAR __builtin_amdgcn_s_barrier()
#define PG8_SCHED __builtin_amdgcn_sched_barrier(0)
#define PG8_UA(u) ((const char*)g.A + 2 * ((size_t)(u).z * g.sAz + (size_t)(u).pm * g.sAm + (size_t)(u).pn * g.sAn))
#define PG8_UB(u) ((const char*)g.Bt + 2 * ((size_t)(u).z * g.sBz + (size_t)(u).pm * g.sBm + (size_t)(u).pn * g.sBn))
    Unit cur, nxt; int ui = 0;
    if (!S.next(0, cur)) return;
    const LAS float* rst = (const LAS float*)(lds + STAGE_BYTES);
    f32x4 acc[2][2][4][2];
    if constexpr (Epi::ACC_INIT) E.init(acc, cur, wr, wc, fr, fq);
    else {
#pragma unroll
    for (int a = 0; a < 2; ++a)
#pragma unroll
        for (int b = 0; b < 2; ++b)
#pragma unroll
            for (int m = 0; m < 4; ++m)
#pragma unroll
                for (int n = 0; n < 2; ++n) acc[a][b][m][n] = (f32x4){0.f, 0.f, 0.f, 0.f};
    }
    bf16x8 At[4][2], B0[2][2], B1[2][2];
    const char* cA = PG8_UA(cur); const char* cB = PG8_UB(cur);
    PG8_STAGE(PG8_SB(0, 0), cB, voffB); PG8_STAGE(PG8_SB(0, 1), cB + hB, voffB); PG8_STAGE(PG8_SA(0, 0), cA, voffA); PG8_STAGE(PG8_SA(0, 1), cA + hA, voffA);
    if constexpr (Epi::NEEDS_RS) {
        for (int i0 = tid >> 8; i0 < 8; i0 += 6) {
            Unit t0, t1, t2; const bool v0 = S.next(i0, t0), v1 = v0 && (i0 + 2 < 8) && S.next(i0 + 2, t1), v2 = v1 && (i0 + 4 < 8) && S.next(i0 + 4, t2);
            if (!v0) break;
            const int rr = tid & 255; f32x4 a[8], b[8], c[8];
            { const f32x4* p = (const f32x4*)(E.part + (size_t)(t0.pm * BM + rr) * 32);
#pragma unroll
              for (int k = 0; k < 8; ++k) a[k] = p[k]; }
            if (v1) { const f32x4* p = (const f32x4*)(E.part + (size_t)(t1.pm * BM + rr) * 32);
#pragma unroll
              for (int k = 0; k < 8; ++k) b[k] = p[k]; }
            if (v2) { const f32x4* p = (const f32x4*)(E.part + (size_t)(t2.pm * BM + rr) * 32);
#pragma unroll
              for (int k = 0; k < 8; ++k) c[k] = p[k]; }
            LAS float* tab = (LAS float*)(lds + STAGE_BYTES);
            { f32x4 s = a[0];
#pragma unroll
              for (int k = 1; k < 8; ++k) s += a[k];
              tab[i0 * 256 + rr] = 1.0f / sqrtf(((s[0] + s[1]) + (s[2] + s[3])) * (1.0f / D) + RMS_EPS); }
            if (v1) { f32x4 s = b[0];
#pragma unroll
              for (int k = 1; k < 8; ++k) s += b[k];
              tab[(i0 + 2) * 256 + rr] = 1.0f / sqrtf(((s[0] + s[1]) + (s[2] + s[3])) * (1.0f / D) + RMS_EPS); }
            if (v2) { f32x4 s = c[0];
#pragma unroll
              for (int k = 1; k < 8; ++k) s += c[k];
              tab[(i0 + 4) * 256 + rr] = 1.0f / sqrtf(((s[0] + s[1]) + (s[2] + s[3])) * (1.0f / D) + RMS_EPS); }
        }
    }
    if (wr == 1) PG8_BAR;
    PG8_WAIT_V(2); PG8_BAR;
    PG8_STAGE(PG8_SB(1, 0), cB + kstepB, voffB); PG8_STAGE(PG8_SA(1, 0), cA + kstepA, voffA); PG8_STAGE(PG8_SB(1, 1), cB + hB + kstepB, voffB);
    PG8_WAIT_V(6); PG8_BAR;
    for (;;) {
        const bool has_next = S.next(ui + 1, nxt);
        const char* nA = has_next ? PG8_UA(nxt) : cA; const char* nB = has_next ? PG8_UB(nxt) : cB;
        for (int t = 0; t < nt; t += 2) {
            const bool last = (t == nt - 2);
            const char* a1 = cA + (size_t)(t + 1) * kstepA;
            const char* a2 = last ? nA : cA + (size_t)(t + 2) * kstepA; const char* b2 = last ? nB : cB + (size_t)(t + 2) * kstepB;
            const char* a3 = a2 + kstepA; const char* b3 = b2 + kstepB;
            PG8_LDB(B0, 0, 0); PG8_LDB(B1, 0, 1); PG8_SCHED; PG8_LDA(At, 0, 0); PG8_STAGE(PG8_SA(1, 1), a1 + hA, voffA);
            PG8_WAIT_V(8); PG8_WAIT_L(0); PG8_BAR; PG8_MMA(0, 0, At, B0); PG8_MMA(0, 1, At, B1); PG8_BAR; PG8_SCHED;
            PG8_LDA(At, 0, 1); PG8_STAGE(PG8_SB(0, 0), b2, voffB); PG8_STAGE(PG8_SB(0, 1), b2 + hB, voffB); PG8_STAGE(PG8_SA(0, 0), a2, voffA);
            PG8_WAIT_V(8); PG8_WAIT_L(0); PG8_BAR; PG8_MMA(1, 0, At, B0); PG8_MMA(1, 1, At, B1); PG8_BAR; PG8_SCHED;
            PG8_LDB(B0, 1, 0); PG8_LDB(B1, 1, 1); PG8_SCHED; PG8_LDA(At, 1, 0); PG8_STAGE(PG8_SA(0, 1), a2 + hA, voffA);
            PG8_WAIT_V(8); PG8_WAIT_L(0); PG8_BAR; PG8_MMA(0, 0, At, B0); PG8_MMA(0, 1, At, B1); PG8_BAR; PG8_SCHED;
            PG8_LDA(At, 1, 1); PG8_STAGE(PG8_SB(1, 0), b3, voffB); PG8_STAGE(PG8_SB(1, 1), b3 + hB, voffB); PG8_STAGE(PG8_SA(1, 0), a3, voffA);
            PG8_WAIT_V(8); PG8_WAIT_L(0); PG8_BAR; PG8_MMA(1, 0, At, B0); PG8_MMA(1, 1, At, B1); PG8_BAR; PG8_SCHED;
        }
        if constexpr (ALIGN_EPI) { if (wr == 0) PG8_BAR; }
        if constexpr (!Epi::AFTER_DRAIN) { E(acc, cur, ui, rst, wr, wc, fr, fq); }
        if (!has_next) break;
        cur = nxt; cA = nA; cB = nB; ++ui;
        if constexpr (Epi::ACC_INIT) E.init(acc, cur, wr, wc, fr, fq);
        else {
#pragma unroll
        for (int a = 0; a < 2; ++a)
#pragma unroll
            for (int b = 0; b < 2; ++b)
#pragma unroll
                for (int m = 0; m < 4; ++m)
#pragma unroll
                    for (int n = 0; n < 2; ++n) acc[a][b][m][n] = (f32x4){0.f, 0.f, 0.f, 0.f};
        }
        if constexpr (ALIGN_EPI) { if (wr == 1) PG8_BAR; }
    }
    PG8_WAIT_V(0);
    if constexpr (!ALIGN_EPI) { if (wr == 0) PG8_BAR; }
    PG8_BAR;
    if constexpr (Epi::AFTER_DRAIN) { E.fused(acc, cur, ui, rst, wr, wc, fr, fq, lds, wid, lane); }
#undef PG8_SA
#undef PG8_SB
#undef PG8_STAGE
#undef PG8_LDA
#undef PG8_LDB
#undef PG8_MMA
#undef PG8_WAIT_V
#undef PG8_WAIT_L
#undef PG8_BAR
#undef PG8_SCHED
#undef PG8_UA
#undef PG8_UB
}
}
using pg8::cvt_pk_bf16;

__device__ __forceinline__ float wave_sum(float v) {
#pragma unroll
    for (int o = 1; o < 64; o <<= 1) v += __shfl_xor(v, o);
    return v;
}
constexpr int TR_LDS_PER_WAVE = 64 * 144;
__device__ __forceinline__ void transpose_item(const float* W, int K, int N, bf16_t* WT, const float* gain, int mode, bool tiled, int item, int lane, LAS unsigned char* scr) {
    const int nblk = N / 64, kb = item / nblk, nb = item % nblk, k0 = 64 * kb, n0 = 64 * nb;
    const float* src = W + (size_t)k0 * N + n0 + lane;
    float v[64];
#pragma unroll
    for (int i = 0; i < 64; ++i) v[i] = __builtin_nontemporal_load(src + (size_t)i * N);
    if (gain) {
#pragma unroll
        for (int i = 0; i < 64; ++i) v[i] *= gain[k0 + i];
    }
    int d0 = n0;
    if (mode == 1) { if (n0 < FF) d0 = (n0 >> 7) * 256 + (n0 & 127); else { const int q = n0 - FF; d0 = (q >> 7) * 256 + 128 + (q & 127); } }
    else if (mode == 2) { if (n0 >= 2 * D) { const int q = n0 - 2 * D; d0 = D + (q >> 7) * 256 + 128 + (q & 127); } else if (n0 >= D) { const int q = n0 - D; d0 = D + (q >> 7) * 256 + (q & 127); } }
    LAS unsigned char* sw = scr + lane * 144;
#pragma unroll
    for (int j = 0; j < 8; ++j) { u32x4 o; o.x = cvt_pk_bf16(v[8 * j], v[8 * j + 1]); o.y = cvt_pk_bf16(v[8 * j + 2], v[8 * j + 3]); o.z = cvt_pk_bf16(v[8 * j + 4], v[8 * j + 5]); o.w = cvt_pk_bf16(v[8 * j + 6], v[8 * j + 7]);
        *(LAS u32x4*)(sw + 16 * j) = o; }
    asm volatile("s_waitcnt lgkmcnt(0)" ::: "memory");
    const int a = lane >> 3, b = lane & 7;
    bf16_t* dst = tiled ? WT + (size_t)((d0 >> 8) * (K / 64) + kb) * (256 * 64) + ((size_t)((b >> 2) * 256 + (d0 & 255) + a) * 32 + 8 * (b & 3)) : WT + (size_t)(d0 + a) * K + k0 + 8 * b;
    const size_t rstep = tiled ? (size_t)8 * 32 : (size_t)8 * K;
#pragma unroll
    for (int s = 0; s < 8; ++s) { const u32x4 c = *(const LAS u32x4*)(scr + (8 * s + a) * 144 + 16 * b); *(u32x4*)(dst + s * rstep) = c; }
    asm volatile("s_waitcnt lgkmcnt(0)" ::: "memory");
}

#define XB_TMO      128
#define XB_XCNT(j)  (256  + 64 * (j))
#define XB_XSUB(j)  (1280 + 64 * (j))
#define XB_XGEN(j)  (2304 + 64 * (j))
#define XB_TOP      3328
#define XB_TOPGEN   3392
#define XCD_BAR_WORDS 3456
#define XB_SPIN_CAP (1u << 18)

__device__ __forceinline__ unsigned xb_ld(unsigned* p)              { return __hip_atomic_load(p, __ATOMIC_RELAXED, __HIP_MEMORY_SCOPE_AGENT); }
__device__ __forceinline__ unsigned xb_add(unsigned* p, unsigned v) { return __hip_atomic_fetch_add(p, v, __ATOMIC_RELAXED, __HIP_MEMORY_SCOPE_AGENT); }
__device__ __forceinline__ unsigned xb_xcc_id() { return (unsigned)__builtin_amdgcn_s_getreg((3 << 11) | 20) & 0xFu; }
#define XB_SPIN(cond, bar) do { unsigned _sp = 0; while (cond) { __builtin_amdgcn_s_sleep(1); \
    if ((++_sp & 255u) == 0u) { if (xb_ld(&(bar)[XB_TMO])) break; if (_sp > XB_SPIN_CAP) { atomicAdd(&(bar)[XB_TMO], 1u); break; } } } } while (0)

struct XcdBarrier {
    unsigned* bar; unsigned x;
    volatile LAS unsigned* st;
};

__device__ __forceinline__ XcdBarrier xcd_barrier_post(unsigned* bar, volatile LAS unsigned* st) {
    XcdBarrier b; b.bar = bar; b.x = xb_xcc_id(); b.st = st;
    if (threadIdx.x == 0) (void)xb_add(&bar[XB_XCNT(b.x)], 1u);
    return b;
}
__device__ __forceinline__ void xcd_barrier_complete(unsigned* bar, unsigned x, unsigned& nloc, unsigned& nx) {
    const unsigned G = gridDim.x * gridDim.y * gridDim.z;
    unsigned sum, cnt, mine, sp = 0u;
    for (;;) {
        sum = 0u; cnt = 0u; mine = 0u;
#pragma unroll
        for (unsigned j = 0; j < 16; ++j) { const unsigned c = xb_ld(&bar[XB_XCNT(j)]); sum += c; cnt += (c > 0u) ? 1u : 0u; mine = (j == x) ? c : mine; }
        if (sum == G) break;
        __builtin_amdgcn_s_sleep(1);
        if ((++sp & 255u) == 0u) { if (xb_ld(&bar[XB_TMO])) break; if (sp > XB_SPIN_CAP) { atomicAdd(&bar[XB_TMO], 1u); break; } }
    }
    nloc = mine > 0u ? mine : 1u; nx = cnt > 0u ? cnt : 1u;
}

__device__ __forceinline__ void xcd_barrier(const XcdBarrier& b) {
    asm volatile("s_waitcnt vmcnt(0)" ::: "memory");
    __syncthreads();
    if (threadIdx.x == 0) {
        unsigned* bar = b.bar;
        __builtin_amdgcn_s_waitcnt(0);
        unsigned nloc = b.st[0], nx = b.st[1];
        if (nloc == 0u) { xcd_barrier_complete(bar, b.x, nloc, nx); b.st[0] = nloc; b.st[1] = nx; }
        const unsigned old = xb_add(&bar[XB_XSUB(b.x)], 1u);
        const unsigned gen = old / nloc;
        if (old + 1u == (gen + 1u) * nloc) {
            __builtin_amdgcn_fence(__ATOMIC_RELEASE, "agent");
            asm volatile("s_waitcnt vmcnt(0)" ::: "memory");
            const unsigned og = xb_add(&bar[XB_TOP], 1u);
            const unsigned tg = og / nx;
            if (og + 1u == (tg + 1u) * nx) xb_add(&bar[XB_TOPGEN], 1u);
            else XB_SPIN(xb_ld(&bar[XB_TOPGEN]) == tg, bar);
            __builtin_amdgcn_fence(__ATOMIC_ACQUIRE, "agent");
            xb_add(&bar[XB_XGEN(b.x)], 1u);
            asm volatile("s_waitcnt vmcnt(0)" ::: "memory");
        } else {
            XB_SPIN(xb_ld(&bar[XB_XGEN(b.x)]) == gen, bar);
            __builtin_amdgcn_fence(__ATOMIC_ACQUIRE, "agent");
            asm volatile("s_waitcnt vmcnt(0)" ::: "memory");
        }
    }
    __syncthreads();
}


struct Args { const float* in[24]; float* out; unsigned char* ws; int ph_lo, ph_hi, coop, pad; };

constexpr int NPHASE = 22;
#define WSP(off) ((bf16_t*)(ws + (off)))
#define IN(k) (lo <= (k) && (k) < hi)
#define SEAM(k) do { if ((k) + 1 < hi && coop) { if (coop == 2) cg::this_grid().sync(); else xcd_barrier(xbar); } } while (0)

template <int MID>
__device__ __forceinline__ void job_setup(const Args& args, unsigned char* ws, const float*& W, int& K, int& N, int& mode, bf16_t*& WT, const float*& gain, bool& tiled) {
    gain = nullptr; mode = 0; tiled = true;
    if constexpr (MID < 4) { constexpr int f = MID >> 1, ll = MID & 1; W = (f ? args.in[21] : args.in[3]) + (size_t)ll * D * 2 * FF; K = D; N = 2 * FF; WT = WSP(WS_W13T) + (size_t)MID * 2 * FF * D; gain = (f ? args.in[20] : args.in[2]) + ll * D; mode = 1; }
    else if constexpr (MID < 8) { constexpr int q = MID - 4, f = q >> 1, ll = q & 1; W = (f ? args.in[22] : args.in[4]) + (size_t)ll * FF * D; K = FF; N = D; WT = WSP(WS_W2T) + (size_t)q * D * FF; }
    else if constexpr (MID == 8) { W = args.in[12]; K = D; N = 3 * D; WT = WSP(WS_CWIN); gain = args.in[5] + D; mode = 2; }
    else if constexpr (MID == 9) { W = args.in[14]; K = D; N = D; WT = WSP(WS_CWOUT); }
    else if constexpr (MID == 10) { W = args.in[6]; K = D; N = 2 * GW; WT = WSP(WS_GWIN); gain = args.in[5]; }
    else if constexpr (MID == 11) { W = args.in[11]; K = GW; N = D; WT = WSP(WS_GWOUT); }
    else if constexpr (MID < 14) { constexpr int ll = MID - 12; W = args.in[18] + (size_t)ll * D * 2 * D; K = D; N = 2 * D; WT = WSP(WS_WKVT) + (size_t)ll * 2 * D * D; }
    else { constexpr int ll = MID - 14; W = args.in[19] + (size_t)ll * D * D; K = D; N = D; WT = WSP(WS_WOT) + (size_t)ll * D * D; tiled = false; }
}
template <int MA, int LOA, int HIA, int MB = -1, int LOB = 0, int HIB = 0, int MC = -1, int LOC = 0, int HIC = 0>
__device__ __forceinline__ void convert_jobs(const Args& args, unsigned char* ws, int gw, int NGW, int lane, LAS unsigned char* scr) {
    constexpr int NA = HIA - LOA, NB = MB >= 0 ? HIB - LOB : 0, NC = MC >= 0 ? HIC - LOC : 0;
    for (int it = gw; it < NA + NB + NC; it += NGW) {
        const float* W; int K, N, mode; bf16_t* WT; const float* gain; bool tiled; int r;
        if (it < NA) { r = LOA + it; job_setup<MA>(args, ws, W, K, N, mode, WT, gain, tiled); }
        else if (it < NA + NB) { r = LOB + it - NA; job_setup<(MB >= 0 ? MB : MA)>(args, ws, W, K, N, mode, WT, gain, tiled); }
        else { r = LOC + it - NA - NB; job_setup<(MC >= 0 ? MC : MA)>(args, ws, W, K, N, mode, WT, gain, tiled); }
        transpose_item(W, K, N, WT, gain, mode, tiled, r, lane, scr);
    }
}
template <int MA, int LOA, int HIA, int MB = -1, int LOB = 0, int HIB = 0, int MC = -1, int LOC = 0, int HIC = 0>
__device__ __forceinline__ void convert_in_slack(const Args& args, LAS unsigned char* lds, unsigned char* ws, int nwg, int G, int bid, int lane, int wave) {
    if constexpr (MA >= 0) {
        const int fs = nwg % G;
        if (bid >= fs) convert_jobs<MA, LOA, HIA, MB, LOB, HIB, MC, LOC, HIC>(args, ws, (bid - fs) * 8 + wave, (G - fs) * 8, lane, lds + wave * TR_LDS_PER_WAVE);
    }
}
__device__ __forceinline__ void wqb_convert(const Args& args, unsigned char* ws, int gt, int NT) {
    bf16_t* WQB = WSP(WS_WQB);
    for (int i = gt; i < 2 * D * D / 8; i += NT) { const size_t e = (size_t)i * 8; const int row = (int)(e / D);
        const float gn = args.in[15][row]; const f32x4 a = *(const f32x4*)(args.in[17] + e) * gn, b = *(const f32x4*)(args.in[17] + e + 4) * gn;
        *(u32x4*)(WQB + e) = pg8::pack8(a, b); }
}

__device__ __forceinline__ void prologue_phase(const Args& args, LAS unsigned char* lds, unsigned char* ws, int G, int bid, int tid, int lane, int wave) {
    bf16_t* XB = WSP(WS_XB); bf16_t* MEMN = WSP(WS_MEMN); bf16_t* WSB = WSP(WS_WSB);
    float* PART = (float*)(ws + WS_PART);
    const int gw = bid * 8 + wave, NGW = G * 8;
    convert_jobs<0, 0, 5632>(args, ws, gw, NGW, lane, lds + wave * TR_LDS_PER_WAVE);
    const int gt = bid * 512 + tid, NT = G * 512;
    for (int i = gt; i < NG * CH * CH / 8; i += NT) { const int e = i * 8, s0 = e & 127, t = (e >> 7) & 127;
        f32x4 a = *(const f32x4*)(args.in[9] + e), b = *(const f32x4*)(args.in[9] + e + 4);
#pragma unroll
        for (int j = 0; j < 4; ++j) { if (s0 + j > t) a[j] = 0.f; if (s0 + 4 + j > t) b[j] = 0.f; }
        *(u32x4*)(WSB + e) = pg8::pack8(a, b); }
    const float* x_in = args.in[0];
    for (int m = gw; m < M; m += NGW) {
        const float* xr = x_in + (size_t)m * D + 8 * lane; float s = 0.f;
#pragma unroll
        for (int j = 0; j < 4; ++j) { const f32x4 a = *(const f32x4*)(xr + 512 * j), b = *(const f32x4*)(xr + 512 * j + 4);
            s += ((a[0] * a[0] + a[1] * a[1]) + (a[2] * a[2] + a[3] * a[3])) + ((b[0] * b[0] + b[1] * b[1]) + (b[2] * b[2] + b[3] * b[3]));
            *(u32x4*)(XB + tm_off(m, 512 * j + 8 * lane, D)) = pg8::pack8(a, b); }
        s = wave_sum(s);
        if (lane < 32) PART[(size_t)m * 32 + lane] = lane == 0 ? s : 0.f;
    }
    for (int m = gw; m < 2 * MEM; m += NGW) { const int ll = m / MEM, row = m % MEM;
        const f32x4* xr = (const f32x4*)(args.in[1] + (size_t)row * D) + lane; const f32x4* gr = (const f32x4*)(args.in[16] + ll * D) + lane; float s = 0.f; f32x4 v[8];
#pragma unroll
        for (int j = 0; j < 8; ++j) { v[j] = xr[64 * j]; s += (v[j][0] * v[j][0] + v[j][1] * v[j][1]) + (v[j][2] * v[j][2] + v[j][3] * v[j][3]); }
        const float rs = 1.0f / sqrtf(wave_sum(s) * (1.0f / D) + RMS_EPS);
#pragma unroll
        for (int j = 0; j < 8; ++j) { const f32x4 o = v[j] * rs * gr[64 * j]; u32x2 w; w.x = cvt_pk_bf16(o[0], o[1]); w.y = cvt_pk_bf16(o[2], o[3]); *((u32x2*)(MEMN + (size_t)m * D) + lane + 64 * j) = w; }
    }
    __syncthreads();
}

__device__ __forceinline__ void spatial_phase(LAS unsigned char* lds, unsigned char* ws, const float* ln_g, const float* ln_b, const float* b_s, int G, int bid, int tid, int lane, int wave) {
    constexpr int VS = 258;
    const bf16_t* UB = WSP(WS_U); const bf16_t* VB = WSP(WS_V); bf16_t* YB = WSP(WS_Y); const bf16_t* WSB = WSP(WS_WSB); const float* LNP = (const float*)(ws + WS_LNP);
    LAS bf16_t* vn = (LAS bf16_t*)lds;
    LAS float* st = (LAS float*)(lds + 66560);
    const int fr = lane & 15, fq = lane >> 4;
    for (int unit = bid; unit < (M / CH) * NG; unit += G) {
        const int c = unit >> 3, gg = unit & 7, pos0 = c * CH, e0 = gg * 256;
        u32x4 rawv[8];
#pragma unroll
        for (int pass = 0; pass < 8; ++pass) rawv[pass] = *(const u32x4*)(VB + tm_off(pos0 + pass * 16 + (tid >> 5), e0 + (tid & 31) * 8, GW));
        if (tid < CH) { const f32x4* p = (const f32x4*)(LNP + (size_t)(pos0 + tid) * 64); float s1 = 0.f, s2 = 0.f;
#pragma unroll
            for (int i = 0; i < 16; ++i) { const f32x4 v = p[i]; s1 += v[0] + v[2]; s2 += v[1] + v[3]; }
            const float mean = s1 * (1.0f / GW), var = fmaxf(s2 * (1.0f / GW) - mean * mean, 0.f);
            st[tid * 2] = mean; st[tid * 2 + 1] = 1.0f / sqrtf(var + LN_EPS); }
        __syncthreads();
        { const int ec = (tid & 31) * 8; const f32x4 g0 = *(const f32x4*)(ln_g + e0 + ec), g1 = *(const f32x4*)(ln_g + e0 + ec + 4), b0 = *(const f32x4*)(ln_b + e0 + ec), b1 = *(const f32x4*)(ln_b + e0 + ec + 4);
#pragma unroll
            for (int pass = 0; pass < 8; ++pass) { const int s = pass * 16 + (tid >> 5);
                const u32x4 raw = rawv[pass]; const float mean = st[s * 2], rstd = st[s * 2 + 1];
                f32x4 a, b;
                a[0] = __uint_as_float(raw.x << 16); a[1] = __uint_as_float(raw.x & 0xffff0000u); a[2] = __uint_as_float(raw.y << 16); a[3] = __uint_as_float(raw.y & 0xffff0000u);
                b[0] = __uint_as_float(raw.z << 16); b[1] = __uint_as_float(raw.z & 0xffff0000u); b[2] = __uint_as_float(raw.w << 16); b[3] = __uint_as_float(raw.w & 0xffff0000u);
                a = (a - mean) * rstd * g0 + b0; b = (b - mean) * rstd * g1 + b1;
                LAS unsigned* dstp = (LAS unsigned*)(vn + s * VS + ec);
                dstp[0] = cvt_pk_bf16(a[0], a[1]); dstp[1] = cvt_pk_bf16(a[2], a[3]); dstp[2] = cvt_pk_bf16(b[0], b[1]); dstp[3] = cvt_pk_bf16(b[2], b[3]); } }
        __syncthreads();
        const int ew = wave * 32;
        bf16x8 af[2][4];
#pragma unroll
        for (int eb = 0; eb < 2; ++eb)
#pragma unroll
            for (int kb = 0; kb < 4; ++kb)
#pragma unroll
                for (int i = 0; i < 8; ++i) af[eb][kb][i] = (short)vn[(32 * kb + 8 * fq + i) * VS + ew + 16 * eb + fr];
#pragma unroll
        for (int tb = 0; tb < 8; ++tb) {
            f32x4 acc0 = (f32x4){0.f, 0.f, 0.f, 0.f}, acc1 = acc0;
            const int t = 16 * tb + fr;
#pragma unroll
            for (int kb = 0; kb < 4; ++kb) if (kb <= tb / 2) {
                const bf16x8 bfr = *(const bf16x8*)(WSB + ((size_t)(gg * CH + t) * CH + 32 * kb + 8 * fq));
                acc0 = __builtin_amdgcn_mfma_f32_16x16x32_bf16(af[0][kb], bfr, acc0, 0, 0, 0);
                acc1 = __builtin_amdgcn_mfma_f32_16x16x32_bf16(af[1][kb], bfr, acc1, 0, 0, 0); }
            const float bias = b_s[gg * CH + t];
#pragma unroll
            for (int eb = 0; eb < 2; ++eb) { const f32x4 a = eb ? acc1 : acc0; const size_t off = (size_t)(pos0 + t) * GW + e0 + ew + 16 * eb + 4 * fq;
                const u32x2 ur = *(const u32x2*)(UB + tm_off(pos0 + t, e0 + ew + 16 * eb + 4 * fq, GW));
                const float u0 = __uint_as_float(ur.x << 16), u1 = __uint_as_float(ur.x & 0xffff0000u), u2 = __uint_as_float(ur.y << 16), u3 = __uint_as_float(ur.y & 0xffff0000u);
                u32x2 w; w.x = cvt_pk_bf16(u0 * (a[0] + bias), u1 * (a[1] + bias)); w.y = cvt_pk_bf16(u2 * (a[2] + bias), u3 * (a[3] + bias));
                *(u32x2*)(YB + tm_off(pos0 + t, e0 + ew + 16 * eb + 4 * fq, GW)) = w; }
        }
        __syncthreads();
    }
}

__device__ __forceinline__ void conv_phase(unsigned char* ws, const float* cw, int G, int bid, int tid) {
    const bf16_t* UB = WSP(WS_U); const bf16_t* VB = WSP(WS_V); bf16_t* YB = WSP(WS_Y);
    for (int i = bid * 512 + tid; i < M * (D / 8); i += G * 512) { const int t = i >> 8, d = (i & 255) * 8; const size_t off = (size_t)t * D + d;
        const u32x4 z0 = *(const u32x4*)(VB + tm_off(t, d, D)), bg = *(const u32x4*)(UB + tm_off(t, d, D));
        u32x4 z1 = (u32x4){0u, 0u, 0u, 0u}, z2 = z1; if (t >= 1) z1 = *(const u32x4*)(VB + tm_off(t - 1, d, D)); if (t >= 2) z2 = *(const u32x4*)(VB + tm_off(t - 2, d, D));
        float y[8];
#pragma unroll
        for (int j = 0; j < 4; ++j) {
            const f32x2 w0 = *(const f32x2*)(cw + d + 2 * j), w1 = *(const f32x2*)(cw + D + d + 2 * j), w2 = *(const f32x2*)(cw + 2 * D + d + 2 * j);
            const float zl0 = __uint_as_float(z0[j] << 16), zh0 = __uint_as_float(z0[j] & 0xffff0000u), zl1 = __uint_as_float(z1[j] << 16), zh1 = __uint_as_float(z1[j] & 0xffff0000u);
            const float zl2 = __uint_as_float(z2[j] << 16), zh2 = __uint_as_float(z2[j] & 0xffff0000u), bl = __uint_as_float(bg[j] << 16), bh = __uint_as_float(bg[j] & 0xffff0000u);
            y[2 * j] = bl * (w0.x * zl2 + w1.x * zl1 + w2.x * zl0); y[2 * j + 1] = bh * (w0.y * zh2 + w1.y * zh1 + w2.y * zh0); }
        u32x4 w; w.x = cvt_pk_bf16(y[0], y[1]); w.y = cvt_pk_bf16(y[2], y[3]); w.z = cvt_pk_bf16(y[4], y[5]); w.w = cvt_pk_bf16(y[6], y[7]);
        *(u32x4*)(YB + tm_off(t, d, D)) = w; }
}

template <int MA, int LOA, int HIA, int MB = -1, int LOB = 0, int HIB = 0, int MC = -1, int LOC = 0, int HIC = 0>
__device__ __forceinline__ void ffn_up_phase(const Args& args, LAS unsigned char* lds, unsigned char* ws, int q, int G, int bid, int lane, int wave) {
    pg8::Gemm g{WSP(WS_XB), WSP(WS_W13T) + (size_t)q * 2 * FF * D, D, D, D, M / 256, 2 * FF / 256, 1, (long)256 * D, 0, 0, 0, (long)256 * D, 0, 1, 1};
    pg8::StaticOrder S; S.init(M / 256, 2 * FF / 256, 1, G, bid);
    pg8::EpiSwiglu E{WSP(WS_H), (const float*)(ws + WS_PART)};
    pg8::gemm_phase<pg8::EpiSwiglu, true>(lds, g, S, E);
    convert_in_slack<MA, LOA, HIA, MB, LOB, HIB, MC, LOC, HIC>(args, lds, ws, (M / 256) * (2 * FF / 256), G, bid, lane, wave);
    if (PROBE_DUP & 512) convert_in_slack<MA, LOA, HIA, MB, LOB, HIB, MC, LOC, HIC>(args, lds, ws, (M / 256) * (2 * FF / 256), G, bid, lane, wave);
}
__device__ __forceinline__ void resid_phase(LAS unsigned char* lds, unsigned char* ws, const bf16_t* A, const bf16_t* Bt, int K, int btile, const float* base, float* X, float alpha, int G, int bid, bool want_xb = true) {
    pg8::Gemm g{A, Bt, K, K, K, M / 256, D / 256, 1, (long)256 * K, 0, 0, 0, (long)256 * K, 0, btile, 1};
    pg8::StaticOrder S; S.init(M / 256, D / 256, 1, G, bid);
    pg8::EpiResid E{nullptr, WSP(WS_XB), (float*)(ws + WS_PART), alpha, 1.0f / alpha};
    pg8::gemm_phase<pg8::EpiResid, true>(lds, g, S, E);
}

template <int L>
__device__ __forceinline__ void layer_phases(const Args& args, LAS unsigned char* lds, unsigned char* ws, const XcdBarrier& xbar, const float* x_in, float* X, const float* p0, const float* p1, const float* p2, int lo, int hi, int coop, int G, int bid, int tid, int lane, int wave) {
    constexpr int PA = (L == 0) ? 1 : 12, P = 3 + 9 * L;
    if (IN(PA)) { if (PROBE_DUP & 2) ffn_up_phase<-1, 0, 0>(args, lds, ws, L, G, bid, lane, wave);
        if constexpr (L == 0) ffn_up_phase<4, 0, 2816, 12, 0, 2048, 13, 0, 2048>(args, lds, ws, L, G, bid, lane, wave);
        else ffn_up_phase<8, 0, 3072, 5, 0, 2816>(args, lds, ws, L, G, bid, lane, wave);
        SEAM(PA); }
    if (IN(PA + 1)) { resid_phase(lds, ws, WSP(WS_H), WSP(WS_W2T) + (size_t)L * D * FF, FF, 1, L == 0 ? x_in : X, X, 0.5f, G, bid);
        if constexpr (L != 0) SEAM(PA + 1);
    }
    if constexpr (L == 0) {
        if (IN(3)) {
            pg8::Gemm g{WSP(WS_MEMN), WSP(WS_WKVT), D, D, D, 1, 16, 2, 0, 0, (long)MEM * D, 0, (long)256 * D, (long)2 * D * D, 1, 0};
            pg8::StaticOrder S; S.init(1, 16, 2, G, bid);
            pg8::EpiBf16 E{WSP(WS_KV), 2 * D, (long)MEM * 2 * D, 1.0f, nullptr};
            pg8::gemm_phase<pg8::EpiBf16, true>(lds, g, S, E);
            if (PROBE_DUP & 128) pg8::gemm_phase<pg8::EpiBf16, true>(lds, g, S, E);
            convert_in_slack<14, 0, 1024, 15, 0, 1024, 10, 0, 2048>(args, lds, ws, 32, G, bid, lane, wave);
            if (bid >= 32 % G) wqb_convert(args, ws, (bid - 32 % G) * 512 + tid, (G - 32 % G) * 512);
            SEAM(3);
        }
        if (IN(4)) {
            { pg8::Gemm g{WSP(WS_KV), WSP(WS_WQB), 2 * D, D, HD, 4, 8, 2, (long)HD, 0, (long)MEM * 2 * D, (long)HD, (long)256 * D, (long)D * D, 0, 0};
              pg8::EpiBf16 E{WSP(WS_WQKT), D, (long)1024 * D, 0.04419417382415922f, nullptr}; pg8::StaticOrder S; S.init(4, 8, 2, G, bid);
              pg8::gemm_phase<pg8::EpiBf16, true>(lds, g, S, E); }
            { pg8::Gemm g{WSP(WS_WOT), WSP(WS_KV) + D, D, 2 * D, HD, 8, 4, 2, (long)256 * D, (long)HD, (long)D * D, 0, (long)HD, (long)MEM * 2 * D, 0, 0};
              pg8::EpiBf16 E{WSP(WS_VWOT), 1024, (long)D * 1024, 1.0f, nullptr}; pg8::StaticOrder S; S.init(8, 4, 2, G, (bid + G / 2) % G);
              pg8::gemm_phase<pg8::EpiBf16, true>(lds, g, S, E); }
            convert_in_slack<11, 0, 1024, 9, 0, 1024>(args, lds, ws, 64, G, bid, lane, wave);
            __syncthreads();
        }
    }
    if (IN(P + 2)) {
        if constexpr (L == 0) {
            pg8::Gemm g{WSP(WS_XB), WSP(WS_GWIN), D, D, D, M / 256, 16, 1, (long)256 * D, 0, 0, 0, (long)256 * D, 0, 1, 1};
            pg8::StaticOrder S; S.init(M / 256, 16, 1, G, bid);
            pg8::EpiGeluUV E{WSP(WS_U), WSP(WS_V), (const float*)(ws + WS_PART), (float*)(ws + WS_LNP)};
            pg8::gemm_phase<pg8::EpiGeluUV, true>(lds, g, S, E);
            if (PROBE_DUP & 8) pg8::gemm_phase<pg8::EpiGeluUV, true>(lds, g, S, E);
        } else {
            pg8::Gemm g{WSP(WS_XB), WSP(WS_CWIN), D, D, D, M / 256, 24, 1, (long)256 * D, 0, 0, 0, (long)256 * D, 0, 1, 1};
            pg8::StaticOrder S; S.init(M / 256, 24, 1, G, bid);
            pg8::EpiConvIn E{WSP(WS_U), WSP(WS_V), (const float*)(ws + WS_PART)};
            pg8::gemm_phase<pg8::EpiConvIn, true>(lds, g, S, E);
            if (PROBE_DUP & 8) pg8::gemm_phase<pg8::EpiConvIn, true>(lds, g, S, E);
        }
        SEAM(P + 2);
    }
    if (IN(P + 3)) {
        if constexpr (L == 0) spatial_phase(lds, ws, p0, p1, p2, G, bid, tid, lane, wave); else conv_phase(ws, p0, G, bid, tid);
        if (PROBE_DUP & 16) { if constexpr (L == 0) spatial_phase(lds, ws, p0, p1, p2, G, bid, tid, lane, wave); else conv_phase(ws, p0, G, bid, tid); }
        SEAM(P + 3);
    }
    if (IN(P + 4)) { resid_phase(lds, ws, WSP(WS_Y), L == 0 ? WSP(WS_GWOUT) : WSP(WS_CWOUT), D, 1, X, X, 1.0f, G, bid); SEAM(P + 4); }
    if (IN(P + 5)) {
        pg8::Gemm g{WSP(WS_XB), WSP(WS_WQKT) + (size_t)L * 1024 * D, D, D, D, M / 256, NH, 1, (long)256 * D, 0, 0, 0, (long)256 * D, 0, 0, 1};
        pg8::StaticOrder S; S.init(M / 256, NH, 1, G, bid);
        pg8::EpiSoftmax E{WSP(WS_P), (const float*)(ws + WS_PART)};
        pg8::gemm_phase<pg8::EpiSoftmax, false>(lds, g, S, E);
        if constexpr (L == 0) convert_in_slack<2, 0, 5632, 6, 0, 1408>(args, lds, ws, (M / 256) * NH, G, bid, lane, wave);
        else convert_in_slack<3, 0, 5632>(args, lds, ws, (M / 256) * NH, G, bid, lane, wave);
        if (PROBE_DUP & 32) pg8::gemm_phase<pg8::EpiSoftmax, false>(lds, g, S, E);
        SEAM(P + 5);
    }
    if (IN(P + 6)) { resid_phase(lds, ws, WSP(WS_P), WSP(WS_VWOT) + (size_t)L * D * 1024, 1024, 0, X, X, 1.0f, G, bid); SEAM(P + 6); }
    if (IN(P + 7)) { if (PROBE_DUP & 2) ffn_up_phase<-1, 0, 0>(args, lds, ws, 2 + L, G, bid, lane, wave);
        if constexpr (L == 0) ffn_up_phase<1, 0, 5632, 6, 1408, 2816>(args, lds, ws, 2 + L, G, bid, lane, wave);
        else ffn_up_phase<7, 0, 2816>(args, lds, ws, 2 + L, G, bid, lane, wave);
        SEAM(P + 7); }
    if (IN(P + 8)) { resid_phase(lds, ws, WSP(WS_H), WSP(WS_W2T) + (size_t)(2 + L) * D * FF, FF, 1, X, X, 0.5f, G, bid, L == 0);   SEAM(P + 8); }
}

__global__ void __launch_bounds__(512, 2) fwd_megakernel(Args args) {
    extern __shared__ __attribute__((aligned(16))) unsigned char lds_raw[];
    LAS unsigned char* lds = (LAS unsigned char*)lds_raw;
    const int tid = threadIdx.x, lane = tid & 63, wave = __builtin_amdgcn_readfirstlane(tid >> 6);
    const int G = gridDim.x, bid = blockIdx.x;
    unsigned char* ws = args.ws;
    float* X = args.out;
    const int lo = args.ph_lo, hi = args.ph_hi, coop = args.coop;
    volatile LAS unsigned* misc = (volatile LAS unsigned*)(lds + LDS_MISC);
    if (tid < 64) misc[tid] = 0u;
    __syncthreads();
    XcdBarrier xbar; xbar.bar = (unsigned*)(ws + WS_BAR); xbar.x = 0; xbar.st = nullptr;
    if (coop) xbar = xcd_barrier_post((unsigned*)(ws + WS_BAR), misc + 8);

    if (IN(0)) { for (int rep = 0; rep < 1 + (PROBE_DUP & 1); ++rep) prologue_phase(args, lds, ws, G, bid, tid, lane, wave); SEAM(0); }
    layer_phases<0>(args, lds, ws, xbar, args.in[0], X, args.in[7], args.in[8], args.in[10], lo, hi, coop, G, bid, tid, lane, wave);
    layer_phases<1>(args, lds, ws, xbar, args.in[0], X, args.in[13], nullptr, nullptr, lo, hi, coop, G, bid, tid, lane, wave);
    if ((PROBE_DUP & 256) && coop) { for (int rep = 0; rep < 40; ++rep) xcd_barrier(xbar); }
    if (IN(21)) {
        const float* gn = args.in[23]; const float* PART = (const float*)(ws + WS_PART); const bf16_t* XBF = WSP(WS_XB);
        const int gw = bid * 8 + wave, NGW = G * 8;
        for (int m = gw; m < M; m += NGW) {
            u32x4 w[4];
#pragma unroll
            for (int j = 0; j < 4; ++j) w[j] = *(const u32x4*)(XBF + tm_off(m, 512 * j + 8 * lane, D));
            float s = PART[(size_t)m * 32 + (lane & 31)];
            s += __shfl_xor(s, 1); s += __shfl_xor(s, 2); s += __shfl_xor(s, 4); s += __shfl_xor(s, 8); s += __shfl_xor(s, 16);
            const float rs = 1.0f / sqrtf(s * (1.0f / D) + RMS_EPS);
            float* orow = X + (size_t)m * D;
#pragma unroll
            for (int j = 0; j < 4; ++j) { const int c = 512 * j + 8 * lane;
                const f32x4 lo = (f32x4){__uint_as_float(w[j].x << 16), __uint_as_float(w[j].x & 0xffff0000u), __uint_as_float(w[j].y << 16), __uint_as_float(w[j].y & 0xffff0000u)};
                const f32x4 hi = (f32x4){__uint_as_float(w[j].z << 16), __uint_as_float(w[j].z & 0xffff0000u), __uint_as_float(w[j].w << 16), __uint_as_float(w[j].w & 0xffff0000u)};
                *(f32x4*)(orow + c) = lo * rs * *(const f32x4*)(gn + c); *(f32x4*)(orow + c + 4) = hi * rs * *(const f32x4*)(gn + c + 4); }
        }
    }
}

extern "C" void kernel_launch(void* const* d_in, const int* in_sizes, int n_in, void* d_out, int out_size, void* d_ws, size_t ws_size, hipStream_t stream) {
    static int grid = 0;
    if (grid == 0) {
        if (n_in != 24 || out_size != M * D || ws_size < WS_END) { fprintf(stderr, "kernel_launch: unexpected shapes: n_in %d out %d ws %zu (need %zu)\n", n_in, out_size, ws_size, (size_t)WS_END); grid = -1; return; }
        int dev = 0, cus = 0, per_cu = 0;
        hipGetDevice(&dev); hipDeviceGetAttribute(&cus, hipDeviceAttributeMultiprocessorCount, dev);
        if (hipFuncSetAttribute((const void*)fwd_megakernel, hipFuncAttributeMaxDynamicSharedMemorySize, LDS_BYTES) != hipSuccess) { fprintf(stderr, "kernel_launch: hipFuncSetAttribute failed\n"); grid = -1; return; }
        if (hipOccupancyMaxActiveBlocksPerMultiprocessor(&per_cu, (const void*)fwd_megakernel, 512, LDS_BYTES) != hipSuccess || per_cu < 1) { fprintf(stderr, "kernel_launch: occupancy query failed (%d)\n", per_cu); per_cu = 1; }
        (void)hipGetLastError();
        grid = cus * per_cu;
        fprintf(stderr, "kernel_launch: grid %d (cus %d x %d)\n", grid, cus, per_cu);
    }
    if (grid < 0) return;
    Args a{};
    for (int i = 0; i < 24; ++i) a.in[i] = (const float*)d_in[i];
    a.out = (float*)d_out; a.ws = (unsigned char*)d_ws;
#if MK_PER_PHASE
    for (int ph = 0; ph < NPHASE; ++ph) { a.ph_lo = ph; a.ph_hi = ph + 1; a.coop = 0;
        hipLaunchKernelGGL(fwd_megakernel, dim3(grid), dim3(512), LDS_BYTES, stream, a); }
#else
    a.ph_lo = 0; a.ph_hi = NPHASE; a.coop = 1;
    if (hipMemsetAsync((char*)d_ws + WS_BAR, 0, 16384, stream) != hipSuccess) { fprintf(stderr, "kernel_launch: memset of barrier words failed\n"); return; }
    void* kargs[] = {&a};
    hipError_t e = hipLaunchCooperativeKernel((const void*)fwd_megakernel, dim3(grid), dim3(512), kargs, LDS_BYTES, stream);
    if (e != hipSuccess) fprintf(stderr, "kernel_launch: cooperative launch failed: %s (grid %d)\n", hipGetErrorString(e), grid);
#endif
}
```

```cpp
#include <hip/hip_runtime.h>
#include <hip/hip_cooperative_groups.h>
#include <cstdio>
#include <cstdint>
namespace cg = cooperative_groups;

#ifndef PROBE_DUP
#define PROBE_DUP 0
#endif
#ifndef MK_PER_PHASE
#define MK_PER_PHASE 0
#endif

constexpr int M = 8192, D = 2048, FF = 5632, MEM = 256, NH = 4, HD = 512, GW = 2048, NG = 8, CH = 128;
constexpr float RMS_EPS = 1e-6f, LN_EPS = 1e-5f;

#define LAS __attribute__((address_space(3)))
typedef unsigned short bf16_t;
typedef short bf16x8 __attribute__((ext_vector_type(8)));
typedef float f32x4 __attribute__((ext_vector_type(4)));
typedef float f32x2 __attribute__((ext_vector_type(2)));
typedef unsigned u32x4 __attribute__((ext_vector_type(4)));
typedef unsigned u32x2 __attribute__((ext_vector_type(2)));

constexpr size_t al(size_t x) { return (x + 4095) & ~(size_t)4095; }
constexpr size_t SZ_W13T = (size_t)2 * FF * D * 2, SZ_W2T = (size_t)D * FF * 2;
constexpr size_t WS_W13T = 0;
constexpr size_t WS_W2T = WS_W13T + 4 * SZ_W13T;
constexpr size_t WS_GWIN = WS_W2T + 4 * SZ_W2T;
constexpr size_t WS_GWOUT = WS_GWIN + (size_t)2 * GW * D * 2;
constexpr size_t WS_CWIN = WS_GWOUT + (size_t)D * GW * 2;
constexpr size_t WS_CWOUT = WS_CWIN + (size_t)3 * D * D * 2;
constexpr size_t WS_WQB = WS_CWOUT + (size_t)D * D * 2;
constexpr size_t WS_WKVT = WS_WQB + (size_t)2 * D * D * 2;
constexpr size_t WS_WOT = WS_WKVT + (size_t)2 * 2 * D * D * 2;
constexpr size_t WS_WQKT = WS_WOT + (size_t)2 * D * D * 2;
constexpr size_t WS_VWOT = WS_WQKT + (size_t)2 * 1024 * D * 2;
constexpr size_t WS_WSB = WS_VWOT + (size_t)2 * D * 1024 * 2;
constexpr size_t WS_MEMN = WS_WSB + (size_t)NG * CH * CH * 2;
constexpr size_t WS_KV = WS_MEMN + (size_t)2 * MEM * D * 2;
constexpr size_t WS_XB = WS_KV + (size_t)2 * MEM * 2 * D * 2;
constexpr size_t WS_H = WS_XB + (size_t)M * D * 2;
constexpr size_t WS_U = WS_H + (size_t)M * FF * 2;
constexpr size_t WS_V = WS_U + (size_t)M * D * 2;
constexpr size_t WS_Y = WS_V + (size_t)M * D * 2;
constexpr size_t WS_P = WS_Y + (size_t)M * D * 2;
constexpr size_t WS_PART = WS_P + (size_t)M * 1024 * 2;
constexpr size_t WS_LNP = WS_PART + (size_t)M * 32 * 4;
constexpr size_t WS_BAR = WS_LNP + (size_t)M * 64 * 4;
constexpr size_t WS_XT = WS_BAR + 16384;
constexpr size_t WS_END = WS_XT + (size_t)M * D * 4;

constexpr int LDS_MISC = 131072 + 8192, LDS_BYTES = LDS_MISC + 256;

__device__ __forceinline__ size_t tm_off(int r, int k, int K) { return ((size_t)((r >> 8) * (K >> 6) + (k >> 6)) << 14) + (size_t)(((((k >> 5) & 1) << 8) + (r & 255)) << 5) + (k & 31); }

namespace pg8 {
constexpr int BM = 256, BK = 64, HALF = 128, HTB = HALF * BK * 2, STAGE_BYTES = 8 * HTB, NXCD = 8, WGM = 8;
__host__ __device__ __forceinline__ int lds_byte(int r, int c) { const int st = (r >> 4) * 2 + (c >> 5), rr = r & 15, cc = c & 31, ob = rr * 64 + cc * 2; return st * 1024 + (ob ^ (((ob >> 9) & 1) << 5)); }
__host__ __device__ __forceinline__ void stage_rc(int b, int& R, int& C) { const int st = b / 1024, sb = b % 1024, swz = sb ^ (((sb >> 9) & 1) << 5); R = (st >> 1) * 16 + swz / 64; C = (st & 1) * 32 + (swz % 64) / 2; }
__host__ __device__ __forceinline__ int perm32(int rho) { const int n = rho >> 4, i = rho & 15; return 8 * (i >> 2) + 4 * n + (i & 3); }

struct Unit { int pm, pn, z; };
struct Gemm { const bf16_t* A; const bf16_t* Bt; int lda, ldb, K, nM, nN, nZ; long sAm, sAn, sAz, sBm, sBn, sBz; int btile, atile; };

struct StaticOrder {
    int nM, nN, nper, nwg, G, c;
    __device__ __forceinline__ void init(int nM_, int nN_, int nZ_, int G_, int c_) { nM = nM_; nN = nN_; nper = nM * nN; nwg = nper * nZ_; G = G_; c = c_; }
    __device__ __forceinline__ bool next(int i, Unit& u) const {
        const long L = (long)i * G + c; if (L >= nwg) return false;
        int wgid = (int)L; { const int q = nwg / NXCD, r = nwg % NXCD, xcd = wgid % NXCD, off = wgid / NXCD; wgid = (xcd < r ? xcd * (q + 1) : r * (q + 1) + (xcd - r) * q) + off; }
        u.z = wgid / nper; wgid -= u.z * nper;
        const int nig = WGM * nN, gid = wgid / nig, fm = gid * WGM, gsz = (nM - fm) < WGM ? (nM - fm) : WGM;
        u.pm = fm + ((wgid % nig) % gsz); u.pn = (wgid % nig) / gsz; return true;
    }
};

__device__ __forceinline__ unsigned cvt_pk_bf16(float lo, float hi) { unsigned r; asm volatile("v_cvt_pk_bf16_f32 %0, %1, %2" : "=v"(r) : "v"(lo), "v"(hi)); return r; }
__device__ __forceinline__ f32x2 gelu_pk(f32x2 v) {
    const f32x2 av = __builtin_elementwise_abs(v), d = av * 0.2316418882f + 1.0f;
    f32x2 t; t.x = __builtin_amdgcn_rcpf(d.x); t.y = __builtin_amdgcn_rcpf(d.y);
    f32x2 q = t * 0.5307027145f + (-0.7265760135f); q = q * t + 0.7107068705f; q = q * t + (-0.142248368f); q = q * t + 0.127414796f; q = q * t;
    const f32x2 s = (v * v) * (-0.72134752044f);
    f32x2 e; e.x = __builtin_amdgcn_exp2f(s.x); e.y = __builtin_amdgcn_exp2f(s.y);
    const f32x2 m = v * (q * e), r = v - m;
    f32x2 o; o.x = v.x < 0.f ? m.x : r.x; o.y = v.y < 0.f ? m.y : r.y; return o;
}
__device__ __forceinline__ f32x4 gelu4(f32x4 v) { const f32x2 a = gelu_pk((f32x2){v[0], v[1]}), b = gelu_pk((f32x2){v[2], v[3]}); return (f32x4){a.x, a.y, b.x, b.y}; }
__device__ __forceinline__ u32x4 pack8(f32x4 a, f32x4 b) { u32x4 w; w.x = cvt_pk_bf16(a[0], a[1]); w.y = cvt_pk_bf16(a[2], a[3]); w.z = cvt_pk_bf16(b[0], b[1]); w.w = cvt_pk_bf16(b[2], b[3]); return w; }
__device__ __forceinline__ float row_rstd(const float* part, int r) {
    const f32x4* p = (const f32x4*)(part + (size_t)r * 32);
    f32x4 s = p[0];
#pragma unroll
    for (int i = 1; i < 8; ++i) s += p[i];
    const float t = (s[0] + s[1]) + (s[2] + s[3]);
    return 1.0f / sqrtf(t * (1.0f / D) + RMS_EPS);
}
__device__ __forceinline__ float tile_rstd(const LAS float* rst, int ui, int rl, const float* part, int r) { return ui < 8 ? rst[ui * 256 + rl] : row_rstd(part, r); }
__device__ __forceinline__ float silu1(float g) { return g * __builtin_amdgcn_rcpf(1.0f + __builtin_amdgcn_exp2f(g * -1.44269504089f)); }

struct EpiBf16 {
    static constexpr bool PERM = true, AFTER_DRAIN = false, NEEDS_RS = false, ACC_INIT = false;
    bf16_t* C; int ldc; long sCz; float scale; const float* part;
    __device__ __forceinline__ void operator()(const f32x4 (&acc)[2][2][4][2], const Unit& u, int ui, const LAS float* rst, int wr, int wc, int fr, int fq) const {
        bf16_t* base = C + (size_t)u.z * sCz + (size_t)(u.pm * BM + wr * 64 + fr) * ldc + u.pn * BM + wc * 32 + 8 * fq;
#pragma unroll
        for (int ai = 0; ai < 2; ++ai)
#pragma unroll
            for (int m = 0; m < 4; ++m)
#pragma unroll
                for (int bj = 0; bj < 2; ++bj)
                    *(u32x4*)(base + (size_t)(ai * HALF + m * 16) * ldc + bj * HALF) = pack8(acc[ai][bj][m][0] * scale, acc[ai][bj][m][1] * scale);
    }
};
struct EpiSwiglu {
    static constexpr bool PERM = true, AFTER_DRAIN = false, NEEDS_RS = true, ACC_INIT = false;
    bf16_t* H; const float* part;
    __device__ __forceinline__ void operator()(const f32x4 (&acc)[2][2][4][2], const Unit& u, int ui, const LAS float* rst, int wr, int wc, int fr, int fq) const {
        const int row0 = u.pm * BM + wr * 64 + fr, col0 = u.pn * HALF + wc * 32 + 8 * fq;
#pragma unroll
        for (int ai = 0; ai < 2; ++ai)
#pragma unroll
            for (int m = 0; m < 4; ++m) {
                const int r = row0 + ai * HALF + m * 16; const float rs = tile_rstd(rst, ui, r - u.pm * BM, part, r), c2 = rs * -1.44269504089f, rs2 = rs * rs;
                f32x4 h[2];
#pragma unroll
                for (int n = 0; n < 2; ++n) {
                    const f32x4 g = acc[ai][0][m][n], t = g * c2;
                    const f32x4 d = (f32x4){__builtin_amdgcn_exp2f(t[0]), __builtin_amdgcn_exp2f(t[1]), __builtin_amdgcn_exp2f(t[2]), __builtin_amdgcn_exp2f(t[3])} + 1.0f;
                    const f32x4 r = (f32x4){__builtin_amdgcn_rcpf(d[0]), __builtin_amdgcn_rcpf(d[1]), __builtin_amdgcn_rcpf(d[2]), __builtin_amdgcn_rcpf(d[3])};
                    h[n] = ((g * acc[ai][1][m][n]) * r) * rs2; }
                *(u32x4*)(H + tm_off(r, col0, FF)) = pack8(h[0], h[1]);
            }
    }
};
struct EpiResid {
    static constexpr bool PERM = true, AFTER_DRAIN = false, NEEDS_RS = false, ACC_INIT = true;
    const float* base_rm; bf16_t* xb; float* part; float alpha, ialpha;
    __device__ __forceinline__ void init(f32x4 (&acc)[2][2][4][2], const Unit& u, int wr, int wc, int fr, int fq) const {
        const int row0 = u.pm * BM + wr * 64 + fr, col0 = u.pn * BM + wc * 32 + 8 * fq;
#pragma unroll
        for (int ai = 0; ai < 2; ++ai)
#pragma unroll
            for (int m = 0; m < 4; ++m)
#pragma unroll
                for (int bj = 0; bj < 2; ++bj) { const u32x4 w = *(const u32x4*)(xb + tm_off(row0 + ai * HALF + m * 16, col0 + bj * HALF, D));
                    acc[ai][bj][m][0] = (f32x4){__uint_as_float(w.x << 16), __uint_as_float(w.x & 0xffff0000u), __uint_as_float(w.y << 16), __uint_as_float(w.y & 0xffff0000u)} * ialpha;
                    acc[ai][bj][m][1] = (f32x4){__uint_as_float(w.z << 16), __uint_as_float(w.z & 0xffff0000u), __uint_as_float(w.w << 16), __uint_as_float(w.w & 0xffff0000u)} * ialpha; }
    }
    __device__ __forceinline__ void operator()(const f32x4 (&acc)[2][2][4][2], const Unit& u, int ui, const LAS float* rst, int wr, int wc, int fr, int fq) const {
        const int row0 = u.pm * BM + wr * 64 + fr, col0 = u.pn * BM + wc * 32 + 8 * fq;
#pragma unroll
        for (int ai = 0; ai < 2; ++ai)
#pragma unroll
            for (int m = 0; m < 4; ++m) {
                const int r = row0 + ai * HALF + m * 16; float ss = 0.f;
#pragma unroll
                for (int bj = 0; bj < 2; ++bj) {
                    const f32x4 o0 = acc[ai][bj][m][0] * alpha, o1 = acc[ai][bj][m][1] * alpha;
                    *(u32x4*)(xb + tm_off(r, col0 + bj * HALF, D)) = pack8(o0, o1);
                    ss += ((o0[0] * o0[0] + o0[1] * o0[1]) + (o0[2] * o0[2] + o0[3] * o0[3])) + ((o1[0] * o1[0] + o1[1] * o1[1]) + (o1[2] * o1[2] + o1[3] * o1[3])); }
                ss += __shfl_xor(ss, 16); ss += __shfl_xor(ss, 32);
                if (fq == 0) part[(size_t)r * 32 + u.pn * 4 + wc] = ss;
            }
    }
};
struct EpiGeluUV {
    static constexpr bool PERM = true, AFTER_DRAIN = false, NEEDS_RS = true, ACC_INIT = false;
    bf16_t* U; bf16_t* V; const float* part; float* lnp;
    __device__ __forceinline__ void operator()(const f32x4 (&acc)[2][2][4][2], const Unit& u, int ui, const LAS float* rst, int wr, int wc, int fr, int fq) const {
        const bool isv = u.pn >= 8; bf16_t* dst = isv ? V : U;
        const int row0 = u.pm * BM + wr * 64 + fr, col0 = (u.pn & 7) * BM + wc * 32 + 8 * fq;
#pragma unroll
        for (int ai = 0; ai < 2; ++ai)
#pragma unroll
            for (int m = 0; m < 4; ++m) {
                const int r = row0 + ai * HALF + m * 16; const float rs = tile_rstd(rst, ui, r - u.pm * BM, part, r); float s1 = 0.f, s2 = 0.f;
#pragma unroll
                for (int bj = 0; bj < 2; ++bj) { const f32x4 a = gelu4(acc[ai][bj][m][0] * rs), b = gelu4(acc[ai][bj][m][1] * rs);
                    *(u32x4*)(dst + tm_off(r, col0 + bj * HALF, GW)) = pack8(a, b);
                    s1 += ((a[0] + a[1]) + (a[2] + a[3])) + ((b[0] + b[1]) + (b[2] + b[3]));
                    s2 += ((a[0] * a[0] + a[1] * a[1]) + (a[2] * a[2] + a[3] * a[3])) + ((b[0] * b[0] + b[1] * b[1]) + (b[2] * b[2] + b[3] * b[3])); }
                if (isv) { s1 += __shfl_xor(s1, 16); s1 += __shfl_xor(s1, 32); s2 += __shfl_xor(s2, 16); s2 += __shfl_xor(s2, 32);
                    if (fq == 0) *(f32x2*)(lnp + ((size_t)r * 32 + (u.pn - 8) * 4 + wc) * 2) = (f32x2){s1, s2}; }
            }
    }
};
struct EpiConvIn {
    static constexpr bool PERM = true, AFTER_DRAIN = false, NEEDS_RS = true, ACC_INIT = false;
    bf16_t* Bg; bf16_t* Z; const float* part;
    __device__ __forceinline__ void operator()(const f32x4 (&acc)[2][2][4][2], const Unit& u, int ui, const LAS float* rst, int wr, int wc, int fr, int fq) const {
        const int row0 = u.pm * BM + wr * 64 + fr;
#pragma unroll
        for (int ai = 0; ai < 2; ++ai)
#pragma unroll
            for (int m = 0; m < 4; ++m) {
                const int r = row0 + ai * HALF + m * 16; const float rs = tile_rstd(rst, ui, r - u.pm * BM, part, r);
                if (u.pn < 8) {
#pragma unroll
                    for (int bj = 0; bj < 2; ++bj) *(u32x4*)(Bg + tm_off(r, u.pn * BM + bj * HALF + wc * 32 + 8 * fq, D)) = pack8(acc[ai][bj][m][0] * rs, acc[ai][bj][m][1] * rs);
                } else {
                    const float r2 = rs * rs;
                    *(u32x4*)(Z + tm_off(r, (u.pn - 8) * HALF + wc * 32 + 8 * fq, D)) = pack8(acc[ai][0][m][0] * acc[ai][1][m][0] * r2, acc[ai][0][m][1] * acc[ai][1][m][1] * r2);
                }
            }
    }
};
struct EpiSoftmax {
    static constexpr bool PERM = true, AFTER_DRAIN = true, NEEDS_RS = true, ACC_INIT = false;
    bf16_t* P; const float* part;
    __device__ __forceinline__ void fused(f32x4 (&acc)[2][2][4][2], const Unit& u, int ui, const LAS float* rst, int wr, int wc, int fr, int fq, LAS unsigned char* lds, int wid, int lane) const {
        LAS float* red = (LAS float*)lds;
        float sm[2][4];
#pragma unroll
        for (int ai = 0; ai < 2; ++ai)
#pragma unroll
            for (int m = 0; m < 4; ++m) {
                const int rl = ai * HALF + wr * 64 + m * 16 + fr; const float rs = tile_rstd(rst, ui, rl, part, u.pm * BM + rl);
                float mx = -3.0e38f;
#pragma unroll
                for (int bj = 0; bj < 2; ++bj)
#pragma unroll
                    for (int n = 0; n < 2; ++n) { f32x4 v = acc[ai][bj][m][n] * rs; acc[ai][bj][m][n] = v; mx = fmaxf(mx, fmaxf(fmaxf(v[0], v[1]), fmaxf(v[2], v[3]))); }
                mx = fmaxf(mx, __shfl_xor(mx, 16)); mx = fmaxf(mx, __shfl_xor(mx, 32));
                if (fq == 0) red[rl * 4 + wc] = mx;
            }
        __syncthreads();
#pragma unroll
        for (int ai = 0; ai < 2; ++ai)
#pragma unroll
            for (int m = 0; m < 4; ++m) {
                const int rl = ai * HALF + wr * 64 + m * 16 + fr; const f32x4 q = *(const LAS f32x4*)(red + rl * 4);
                const float mx = fmaxf(fmaxf(q[0], q[1]), fmaxf(q[2], q[3])); float s = 0.f;
#pragma unroll
                for (int bj = 0; bj < 2; ++bj)
#pragma unroll
                    for (int n = 0; n < 2; ++n) { f32x4 v = (acc[ai][bj][m][n] - mx) * 1.44269504089f;
                        v = (f32x4){__builtin_amdgcn_exp2f(v[0]), __builtin_amdgcn_exp2f(v[1]), __builtin_amdgcn_exp2f(v[2]), __builtin_amdgcn_exp2f(v[3])};
                        acc[ai][bj][m][n] = v; s += (v[0] + v[1]) + (v[2] + v[3]); }
                s += __shfl_xor(s, 16); s += __shfl_xor(s, 32); sm[ai][m] = s;
            }
        __syncthreads();
#pragma unroll
        for (int ai = 0; ai < 2; ++ai)
#pragma unroll
            for (int m = 0; m < 4; ++m) { const int rl = ai * HALF + wr * 64 + m * 16 + fr; if (fq == 0) red[rl * 4 + wc] = sm[ai][m]; }
        __syncthreads();
#pragma unroll
        for (int ai = 0; ai < 2; ++ai)
#pragma unroll
            for (int m = 0; m < 4; ++m) {
                const int rl = ai * HALF + wr * 64 + m * 16 + fr; const f32x4 q = *(const LAS f32x4*)(red + rl * 4);
                const float inv = 1.0f / ((q[0] + q[1]) + (q[2] + q[3]));
#pragma unroll
                for (int bj = 0; bj < 2; ++bj)
                    *(u32x4*)(P + tm_off(u.pm * BM + rl, u.pn * BM + bj * HALF + wc * 32 + 8 * fq, 1024)) = pack8(acc[ai][bj][m][0] * inv, acc[ai][bj][m][1] * inv);
            }
        __syncthreads();
    }
};

template <class Epi, bool ALIGN_EPI>
__device__ __forceinline__ void gemm_phase(LAS unsigned char* lds, const Gemm g, const StaticOrder& S, const Epi& E) {
    const int tid = threadIdx.x, wid = __builtin_amdgcn_readfirstlane(tid >> 6), lane = tid & 63, wr = wid >> 2, wc = wid & 3, fr = lane & 15, fq = lane >> 4;
    const int nt = g.K / BK;
    unsigned voffA[2], voffB[2];
#pragma unroll
    for (int i = 0; i < 2; ++i) { int R, C; stage_rc(tid * 16 + i * 8192, R, C); const int Rb = Epi::PERM ? ((R & ~31) + perm32(R & 31)) : R;
        voffA[i] = g.atile ? (unsigned)((((C >> 5) * BM + R) * 32) + (C & 31)) * 2u : (unsigned)(R * g.lda + C) * 2u; voffB[i] = g.btile ? (unsigned)((((C >> 5) * BM + Rb) * 32) + (C & 31)) * 2u : (unsigned)(Rb * g.ldb + C) * 2u; }
    const size_t kstepA = g.atile ? (size_t)(BM * BK * 2) : (size_t)(BK * 2), kstepB = g.btile ? (size_t)(BM * BK * 2) : (size_t)(BK * 2);
    const size_t hA = g.atile ? (size_t)(HALF * 32 * 2) : (size_t)HALF * g.lda * 2, hB = g.btile ? (size_t)(HALF * 32 * 2) : (size_t)HALF * g.ldb * 2;
    const unsigned ldsw = (unsigned)wid * 1024u;
    const int aoff = lds_byte(wr * 64 + fr, fq * 8), boff = lds_byte(wc * 32 + fr, fq * 8);
#define PG8_SA(b, h) (((b) * 2 + (h)) * HTB)
#define PG8_SB(b, h) ((4 + (b) * 2 + (h)) * HTB)
#define PG8_STAGE(bufoff, gbase, voff) do { _Pragma("unroll") for (int _i = 0; _i < 2; ++_i) \
        __builtin_amdgcn_global_load_lds((const unsigned*)((const char*)(gbase) + (voff)[_i]), (LAS unsigned*)(lds + (bufoff) + ldsw + _i * 8192), 16, 0, 0); } while (0)
#define PG8_LDA(dst, b, h) do { _Pragma("unroll") for (int m = 0; m < 4; ++m) _Pragma("unroll") for (int k = 0; k < 2; ++k) dst[m][k] = *(const LAS bf16x8*)(lds + PG8_SA(b, h) + aoff + m * 2048 + k * 1024); } while (0)
#define PG8_LDB(dst, b, h) do { _Pragma("unroll") for (int n = 0; n < 2; ++n) _Pragma("unroll") for (int k = 0; k < 2; ++k) dst[n][k] = *(const LAS bf16x8*)(lds + PG8_SB(b, h) + boff + n * 2048 + k * 1024); } while (0)
#define PG8_MMA(ai, bj, At, Bt) do { __builtin_amdgcn_s_setprio(1); _Pragma("unroll") for (int m = 0; m < 4; ++m) _Pragma("unroll") for (int n = 0; n < 2; ++n) _Pragma("unroll") for (int k = 0; k < 2; ++k) \
        acc[ai][bj][m][n] = __builtin_amdgcn_mfma_f32_16x16x32_bf16(Bt[n][k], At[m][k], acc[ai][bj][m][n], 0, 0, 0); __builtin_amdgcn_s_setprio(0); } while (0)
#define PG8_WAIT_V(n) asm volatile("s_waitcnt vmcnt(" #n ")" ::: "memory")
#define PG8_WAIT_L(n) asm volatile("s_waitcnt lgkmcnt(" #n ")" ::: "memory")
#define PG8_BAR __builtin_amdgcn_s_barrier()
#define PG8_SCHED __builtin_amdgcn_sched_barrier(0)
#define PG8_UA(u) ((const char*)g.A + 2 * ((size_t)(u).z * g.sAz + (size_t)(u).pm * g.sAm + (size_t)(u).pn * g.sAn))
#define PG8_UB(u) ((const char*)g.Bt + 2 * ((size_t)(u).z * g.sBz + (size_t)(u).pm * g.sBm + (size_t)(u).pn * g.sBn))
    Unit cur, nxt; int ui = 0;
    if (!S.next(0, cur)) return;
    const LAS float* rst = (const LAS float*)(lds + STAGE_BYTES);
    f32x4 acc[2][2][4][2];
    if constexpr (Epi::ACC_INIT) E.init(acc, cur, wr, wc, fr, fq);
    else {
#pragma unroll
    for (int a = 0; a < 2; ++a)
#pragma unroll
        for (int b = 0; b < 2; ++b)
#pragma unroll
            for (int m = 0; m < 4; ++m)
#pragma unroll
                for (int n = 0; n < 2; ++n) acc[a][b][m][n] = (f32x4){0.f, 0.f, 0.f, 0.f};
    }
    bf16x8 At[4][2], B0[2][2], B1[2][2];
    const char* cA = PG8_UA(cur); const char* cB = PG8_UB(cur);
    PG8_STAGE(PG8_SB(0, 0), cB, voffB); PG8_STAGE(PG8_SB(0, 1), cB + hB, voffB); PG8_STAGE(PG8_SA(0, 0), cA, voffA); PG8_STAGE(PG8_SA(0, 1), cA + hA, voffA);
    if constexpr (Epi::NEEDS_RS) {
        for (int i0 = tid >> 8; i0 < 8; i0 += 6) {
            Unit t0, t1, t2; const bool v0 = S.next(i0, t0), v1 = v0 && (i0 + 2 < 8) && S.next(i0 + 2, t1), v2 = v1 && (i0 + 4 < 8) && S.next(i0 + 4, t2);
            if (!v0) break;
            const int rr = tid & 255; f32x4 a[8], b[8], c[8];
            { const f32x4* p = (const f32x4*)(E.part + (size_t)(t0.pm * BM + rr) * 32);
#pragma unroll
              for (int k = 0; k < 8; ++k) a[k] = p[k]; }
            if (v1) { const f32x4* p = (const f32x4*)(E.part + (size_t)(t1.pm * BM + rr) * 32);
#pragma unroll
              for (int k = 0; k < 8; ++k) b[k] = p[k]; }
            if (v2) { const f32x4* p = (const f32x4*)(E.part + (size_t)(t2.pm * BM + rr) * 32);
#pragma unroll
              for (int k = 0; k < 8; ++k) c[k] = p[k]; }
            LAS float* tab = (LAS float*)(lds + STAGE_BYTES);
            { f32x4 s = a[0];
#pragma unroll
              for (int k = 1; k < 8; ++k) s += a[k];
              tab[i0 * 256 + rr] = 1.0f / sqrtf(((s[0] + s[1]) + (s[2] + s[3])) * (1.0f / D) + RMS_EPS); }
            if (v1) { f32x4 s = b[0];
#pragma unroll
              for (int k = 1; k < 8; ++k) s += b[k];
              tab[(i0 + 2) * 256 + rr] = 1.0f / sqrtf(((s[0] + s[1]) + (s[2] + s[3])) * (1.0f / D) + RMS_EPS); }
            if (v2) { f32x4 s = c[0];
#pragma unroll
              for (int k = 1; k < 8; ++k) s += c[k];
              tab[(i0 + 4) * 256 + rr] = 1.0f / sqrtf(((s[0] + s[1]) + (s[2] + s[3])) * (1.0f / D) + RMS_EPS); }
        }
    }
    if (wr == 1) PG8_BAR;
    PG8_WAIT_V(2); PG8_BAR;
    PG8_STAGE(PG8_SB(1, 0), cB + kstepB, voffB); PG8_STAGE(PG8_SA(1, 0), cA + kstepA, voffA); PG8_STAGE(PG8_SB(1, 1), cB + hB + kstepB, voffB);
    PG8_WAIT_V(6); PG8_BAR;
    for (;;) {
        const bool has_next = S.next(ui + 1, nxt);
        const char* nA = has_next ? PG8_UA(nxt) : cA; const char* nB = has_next ? PG8_UB(nxt) : cB;
        for (int t = 0; t < nt; t += 2) {
            const bool last = (t == nt - 2);
            const char* a1 = cA + (size_t)(t + 1) * kstepA;
            const char* a2 = last ? nA : cA + (size_t)(t + 2) * kstepA; const char* b2 = last ? nB : cB + (size_t)(t + 2) * kstepB;
            const char* a3 = a2 + kstepA; const char* b3 = b2 + kstepB;
            PG8_LDB(B0, 0, 0); PG8_LDB(B1, 0, 1); PG8_SCHED; PG8_LDA(At, 0, 0); PG8_STAGE(PG8_SA(1, 1), a1 + hA, voffA);
            PG8_WAIT_V(8); PG8_WAIT_L(0); PG8_BAR; PG8_MMA(0, 0, At, B0); PG8_MMA(0, 1, At, B1); PG8_BAR; PG8_SCHED;
            PG8_LDA(At, 0, 1); PG8_STAGE(PG8_SB(0, 0), b2, voffB); PG8_STAGE(PG8_SB(0, 1), b2 + hB, voffB); PG8_STAGE(PG8_SA(0, 0), a2, voffA);
            PG8_WAIT_V(8); PG8_WAIT_L(0); PG8_BAR; PG8_MMA(1, 0, At, B0); PG8_MMA(1, 1, At, B1); PG8_BAR; PG8_SCHED;
            PG8_LDB(B0, 1, 0); PG8_LDB(B1, 1, 1); PG8_SCHED; PG8_LDA(At, 1, 0); PG8_STAGE(PG8_SA(0, 1), a2 + hA, voffA);
            PG8_WAIT_V(8); PG8_WAIT_L(0); PG8_BAR; PG8_MMA(0, 0, At, B0); PG8_MMA(0, 1, At, B1); PG8_BAR; PG8_SCHED;
            PG8_LDA(At, 1, 1); PG8_STAGE(PG8_SB(1, 0), b3, voffB); PG8_STAGE(PG8_SB(1, 1), b3 + hB, voffB); PG8_STAGE(PG8_SA(1, 0), a3, voffA);
            PG8_WAIT_V(8); PG8_WAIT_L(0); PG8_BAR; PG8_MMA(1, 0, At, B0); PG8_MMA(1, 1, At, B1); PG8_BAR; PG8_SCHED;
        }
        if constexpr (ALIGN_EPI) { if (wr == 0) PG8_BAR; }
        if constexpr (!Epi::AFTER_DRAIN) { E(acc, cur, ui, rst, wr, wc, fr, fq); }
        if (!has_next) break;
        cur = nxt; cA = nA; cB = nB; ++ui;
        if constexpr (Epi::ACC_INIT) E.init(acc, cur, wr, wc, fr, fq);
        else {
#pragma unroll
        for (int a = 0; a < 2; ++a)
#pragma unroll
            for (int b = 0; b < 2; ++b)
#pragma unroll
                for (int m = 0; m < 4; ++m)
#pragma unroll
                    for (int n = 0; n < 2; ++n) acc[a][b][m][n] = (f32x4){0.f, 0.f, 0.f, 0.f};
        }
        if constexpr (ALIGN_EPI) { if (wr == 1) PG8_BAR; }
    }
    PG8_WAIT_V(0);
    if constexpr (!ALIGN_EPI) { if (wr == 0) PG8_BAR; }
    PG8_BAR;
    if constexpr (Epi::AFTER_DRAIN) { E.fused(acc, cur, ui, rst, wr, wc, fr, fq, lds, wid, lane); }
#undef PG8_SA
#undef PG8_SB
#undef PG8_STAGE
#undef PG8_LDA
#undef PG8_LDB
#undef PG8_MMA
#undef PG8_WAIT_V
#undef PG8_WAIT_L
#undef PG8_BAR
#undef PG8_SCHED
#undef PG8_UA
#undef PG8_UB
}
}
using pg8::cvt_pk_bf16;

__device__ __forceinline__ float wave_sum(float v) {
#pragma unroll
    for (int o = 1; o < 64; o <<= 1) v += __shfl_xor(v, o);
    return v;
}
constexpr int TR_LDS_PER_WAVE = 64 * 144;
__device__ __forceinline__ void transpose_item(const float* W, int K, int N, bf16_t* WT, const float* gain, int mode, bool tiled, int item, int lane, LAS unsigned char* scr) {
    const int nblk = N / 64, kb = item / nblk, nb = item % nblk, k0 = 64 * kb, n0 = 64 * nb;
    const float* src = W + (size_t)k0 * N + n0 + lane;
    float v[64];
#pragma unroll
    for (int i = 0; i < 64; ++i) v[i] = __builtin_nontemporal_load(src + (size_t)i * N);
    if (gain) {
#pragma unroll
        for (int i = 0; i < 64; ++i) v[i] *= gain[k0 + i];
    }
    int d0 = n0;
    if (mode == 1) { if (n0 < FF) d0 = (n0 >> 7) * 256 + (n0 & 127); else { const int q = n0 - FF; d0 = (q >> 7) * 256 + 128 + (q & 127); } }
    else if (mode == 2) { if (n0 >= 2 * D) { const int q = n0 - 2 * D; d0 = D + (q >> 7) * 256 + 128 + (q & 127); } else if (n0 >= D) { const int q = n0 - D; d0 = D + (q >> 7) * 256 + (q & 127); } }
    LAS unsigned char* sw = scr + lane * 144;
#pragma unroll
    for (int j = 0; j < 8; ++j) { u32x4 o; o.x = cvt_pk_bf16(v[8 * j], v[8 * j + 1]); o.y = cvt_pk_bf16(v[8 * j + 2], v[8 * j + 3]); o.z = cvt_pk_bf16(v[8 * j + 4], v[8 * j + 5]); o.w = cvt_pk_bf16(v[8 * j + 6], v[8 * j + 7]);
        *(LAS u32x4*)(sw + 16 * j) = o; }
    asm volatile("s_waitcnt lgkmcnt(0)" ::: "memory");
    const int a = lane >> 3, b = lane & 7;
    bf16_t* dst = tiled ? WT + (size_t)((d0 >> 8) * (K / 64) + kb) * (256 * 64) + ((size_t)((b >> 2) * 256 + (d0 & 255) + a) * 32 + 8 * (b & 3)) : WT + (size_t)(d0 + a) * K + k0 + 8 * b;
    const size_t rstep = tiled ? (size_t)8 * 32 : (size_t)8 * K;
#pragma unroll
    for (int s = 0; s < 8; ++s) { const u32x4 c = *(const LAS u32x4*)(scr + (8 * s + a) * 144 + 16 * b); *(u32x4*)(dst + s * rstep) = c; }
    asm volatile("s_waitcnt lgkmcnt(0)" ::: "memory");
}

#define XB_TMO      128
#define XB_XCNT(j)  (256  + 64 * (j))
#define XB_XSUB(j)  (1280 + 64 * (j))
#define XB_XGEN(j)  (2304 + 64 * (j))
#define XB_TOP      3328
#define XB_TOPGEN   3392
#define XCD_BAR_WORDS 3456
#define XB_SPIN_CAP (1u << 18)

__device__ __forceinline__ unsigned xb_ld(unsigned* p)              { return __hip_atomic_load(p, __ATOMIC_RELAXED, __HIP_MEMORY_SCOPE_AGENT); }
__device__ __forceinline__ unsigned xb_add(unsigned* p, unsigned v) { return __hip_atomic_fetch_add(p, v, __ATOMIC_RELAXED, __HIP_MEMORY_SCOPE_AGENT); }
__device__ __forceinline__ unsigned xb_xcc_id() { return (unsigned)__builtin_amdgcn_s_getreg((3 << 11) | 20) & 0xFu; }
#define XB_SPIN(cond, bar) do { unsigned _sp = 0; while (cond) { __builtin_amdgcn_s_sleep(1); \
    if ((++_sp & 255u) == 0u) { if (xb_ld(&(bar)[XB_TMO])) break; if (_sp > XB_SPIN_CAP) { atomicAdd(&(bar)[XB_TMO], 1u); break; } } } } while (0)

struct XcdBarrier {
    unsigned* bar; unsigned x;
    volatile LAS unsigned* st;
};

__device__ __forceinline__ XcdBarrier xcd_barrier_post(unsigned* bar, volatile LAS unsigned* st) {
    XcdBarrier b; b.bar = bar; b.x = xb_xcc_id(); b.st = st;
    if (threadIdx.x == 0) (void)xb_add(&bar[XB_XCNT(b.x)], 1u);
    return b;
}
__device__ __forceinline__ void xcd_barrier_complete(unsigned* bar, unsigned x, unsigned& nloc, unsigned& nx) {
    const unsigned G = gridDim.x * gridDim.y * gridDim.z;
    unsigned sum, cnt, mine, sp = 0u;
    for (;;) {
        sum = 0u; cnt = 0u; mine = 0u;
#pragma unroll
        for (unsigned j = 0; j < 16; ++j) { const unsigned c = xb_ld(&bar[XB_XCNT(j)]); sum += c; cnt += (c > 0u) ? 1u : 0u; mine = (j == x) ? c : mine; }
        if (sum == G) break;
        __builtin_amdgcn_s_sleep(1);
        if ((++sp & 255u) == 0u) { if (xb_ld(&bar[XB_TMO])) break; if (sp > XB_SPIN_CAP) { atomicAdd(&bar[XB_TMO], 1u); break; } }
    }
    nloc = mine > 0u ? mine : 1u; nx = cnt > 0u ? cnt : 1u;
}

__device__ __forceinline__ void xcd_barrier(const XcdBarrier& b) {
    asm volatile("s_waitcnt vmcnt(0)" ::: "memory");
    __syncthreads();
    if (threadIdx.x == 0) {
        unsigned* bar = b.bar;
        __builtin_amdgcn_s_waitcnt(0);
        unsigned nloc = b.st[0], nx = b.st[1];
        if (nloc == 0u) { xcd_barrier_complete(bar, b.x, nloc, nx); b.st[0] = nloc; b.st[1] = nx; }
        const unsigned old = xb_add(&bar[XB_XSUB(b.x)], 1u);
        const unsigned gen = old / nloc;
        if (old + 1u == (gen + 1u) * nloc) {
            __builtin_amdgcn_fence(__ATOMIC_RELEASE, "agent");
            asm volatile("s_waitcnt vmcnt(0)" ::: "memory");
            const unsigned og = xb_add(&bar[XB_TOP], 1u);
            const unsigned tg = og / nx;
            if (og + 1u == (tg + 1u) * nx) xb_add(&bar[XB_TOPGEN], 1u);
            else XB_SPIN(xb_ld(&bar[XB_TOPGEN]) == tg, bar);
            __builtin_amdgcn_fence(__ATOMIC_ACQUIRE, "agent");
            xb_add(&bar[XB_XGEN(b.x)], 1u);
            asm volatile("s_waitcnt vmcnt(0)" ::: "memory");
        } else {
            XB_SPIN(xb_ld(&bar[XB_XGEN(b.x)]) == gen, bar);
            __builtin_amdgcn_fence(__ATOMIC_ACQUIRE, "agent");
            asm volatile("s_waitcnt vmcnt(0)" ::: "memory");
        }
    }
    __syncthreads();
}


struct Args { const float* in[24]; float* out; unsigned char* ws; int ph_lo, ph_hi, coop, pad; };

constexpr int NPHASE = 22;
#define WSP(off) ((bf16_t*)(ws + (off)))
#define IN(k) (lo <= (k) && (k) < hi)
#define SEAM(k) do { if ((k) + 1 < hi && coop) { if (coop == 2) cg::this_grid().sync(); else xcd_barrier(xbar); } } while (0)

template <int MID>
__device__ __forceinline__ void job_setup(const Args& args, unsigned char* ws, const float*& W, int& K, int& N, int& mode, bf16_t*& WT, const float*& gain, bool& tiled) {
    gain = nullptr; mode = 0; tiled = true;
    if constexpr (MID < 4) { constexpr int f = MID >> 1, ll = MID & 1; W = (f ? args.in[21] : args.in[3]) + (size_t)ll * D * 2 * FF; K = D; N = 2 * FF; WT = WSP(WS_W13T) + (size_t)MID * 2 * FF * D; gain = (f ? args.in[20] : args.in[2]) + ll * D; mode = 1; }
    else if constexpr (MID < 8) { constexpr int q = MID - 4, f = q >> 1, ll = q & 1; W = (f ? args.in[22] : args.in[4]) + (size_t)ll * FF * D; K = FF; N = D; WT = WSP(WS_W2T) + (size_t)q * D * FF; }
    else if constexpr (MID == 8) { W = args.in[12]; K = D; N = 3 * D; WT = WSP(WS_CWIN); gain = args.in[5] + D; mode = 2; }
    else if constexpr (MID == 9) { W = args.in[14]; K = D; N = D; WT = WSP(WS_CWOUT); }
    else if constexpr (MID == 10) { W = args.in[6]; K = D; N = 2 * GW; WT = WSP(WS_GWIN); gain = args.in[5]; }
    else if constexpr (MID == 11) { W = args.in[11]; K = GW; N = D; WT = WSP(WS_GWOUT); }
    else if constexpr (MID < 14) { constexpr int ll = MID - 12; W = args.in[18] + (size_t)ll * D * 2 * D; K = D; N = 2 * D; WT = WSP(WS_WKVT) + (size_t)ll * 2 * D * D; }
    else { constexpr int ll = MID - 14; W = args.in[19] + (size_t)ll * D * D; K = D; N = D; WT = WSP(WS_WOT) + (size_t)ll * D * D; tiled = false; }
}
template <int MA, int LOA, int HIA, int MB = -1, int LOB = 0, int HIB = 0, int MC = -1, int LOC = 0, int HIC = 0>
__device__ __forceinline__ void convert_jobs(const Args& args, unsigned char* ws, int gw, int NGW, int lane, LAS unsigned char* scr) {
    constexpr int NA = HIA - LOA, NB = MB >= 0 ? HIB - LOB : 0, NC = MC >= 0 ? HIC - LOC : 0;
    for (int it = gw; it < NA + NB + NC; it += NGW) {
        const float* W; int K, N, mode; bf16_t* WT; const float* gain; bool tiled; int r;
        if (it < NA) { r = LOA + it; job_setup<MA>(args, ws, W, K, N, mode, WT, gain, tiled); }
        else if (it < NA + NB) { r = LOB + it - NA; job_setup<(MB >= 0 ? MB : MA)>(args, ws, W, K, N, mode, WT, gain, tiled); }
        else { r = LOC + it - NA - NB; job_setup<(MC >= 0 ? MC : MA)>(args, ws, W, K, N, mode, WT, gain, tiled); }
        transpose_item(W, K, N, WT, gain, mode, tiled, r, lane, scr);
    }
}
template <int MA, int LOA, int HIA, int MB = -1, int LOB = 0, int HIB = 0, int MC = -1, int LOC = 0, int HIC = 0>
__device__ __forceinline__ void convert_in_slack(const Args& args, LAS unsigned char* lds, unsigned char* ws, int nwg, int G, int bid, int lane, int wave) {
    if constexpr (MA >= 0) {
        const int fs = nwg % G;
        if (bid >= fs) convert_jobs<MA, LOA, HIA, MB, LOB, HIB, MC, LOC, HIC>(args, ws, (bid - fs) * 8 + wave, (G - fs) * 8, lane, lds + wave * TR_LDS_PER_WAVE);
    }
}
__device__ __forceinline__ void wqb_convert(const Args& args, unsigned char* ws, int gt, int NT) {
    bf16_t* WQB = WSP(WS_WQB);
    for (int i = gt; i < 2 * D * D / 8; i += NT) { const size_t e = (size_t)i * 8; const int row = (int)(e / D);
        const float gn = args.in[15][row]; const f32x4 a = *(const f32x4*)(args.in[17] + e) * gn, b = *(const f32x4*)(args.in[17] + e + 4) * gn;
        *(u32x4*)(WQB + e) = pg8::pack8(a, b); }
}

__device__ __forceinline__ void prologue_phase(const Args& args, LAS unsigned char* lds, unsigned char* ws, int G, int bid, int tid, int lane, int wave) {
    bf16_t* XB = WSP(WS_XB); bf16_t* MEMN = WSP(WS_MEMN); bf16_t* WSB = WSP(WS_WSB);
    float* PART = (float*)(ws + WS_PART);
    const int gw = bid * 8 + wave, NGW = G * 8;
    convert_jobs<0, 0, 5632>(args, ws, gw, NGW, lane, lds + wave * TR_LDS_PER_WAVE);
    const int gt = bid * 512 + tid, NT = G * 512;
    for (int i = gt; i < NG * CH * CH / 8; i += NT) { const int e = i * 8, s0 = e & 127, t = (e >> 7) & 127;
        f32x4 a = *(const f32x4*)(args.in[9] + e), b = *(const f32x4*)(args.in[9] + e + 4);
#pragma unroll
        for (int j = 0; j < 4; ++j) { if (s0 + j > t) a[j] = 0.f; if (s0 + 4 + j > t) b[j] = 0.f; }
        *(u32x4*)(WSB + e) = pg8::pack8(a, b); }
    const float* x_in = args.in[0];
    for (int m = gw; m < M; m += NGW) {
        const float* xr = x_in + (size_t)m * D + 8 * lane; float s = 0.f;
#pragma unroll
        for (int j = 0; j < 4; ++j) { const f32x4 a = *(const f32x4*)(xr + 512 * j), b = *(const f32x4*)(xr + 512 * j + 4);
            s += ((a[0] * a[0] + a[1] * a[1]) + (a[2] * a[2] + a[3] * a[3])) + ((b[0] * b[0] + b[1] * b[1]) + (b[2] * b[2] + b[3] * b[3]));
            *(u32x4*)(XB + tm_off(m, 512 * j + 8 * lane, D)) = pg8::pack8(a, b); }
        s = wave_sum(s);
        if (lane < 32) PART[(size_t)m * 32 + lane] = lane == 0 ? s : 0.f;
    }
    for (int m = gw; m < 2 * MEM; m += NGW) { const int ll = m / MEM, row = m % MEM;
        const f32x4* xr = (const f32x4*)(args.in[1] + (size_t)row * D) + lane; const f32x4* gr = (const f32x4*)(args.in[16] + ll * D) + lane; float s = 0.f; f32x4 v[8];
#pragma unroll
        for (int j = 0; j < 8; ++j) { v[j] = xr[64 * j]; s += (v[j][0] * v[j][0] + v[j][1] * v[j][1]) + (v[j][2] * v[j][2] + v[j][3] * v[j][3]); }
        const float rs = 1.0f / sqrtf(wave_sum(s) * (1.0f / D) + RMS_EPS);
#pragma unroll
        for (int j = 0; j < 8; ++j) { const f32x4 o = v[j] * rs * gr[64 * j]; u32x2 w; w.x = cvt_pk_bf16(o[0], o[1]); w.y = cvt_pk_bf16(o[2], o[3]); *((u32x2*)(MEMN + (size_t)m * D) + lane + 64 * j) = w; }
    }
    __syncthreads();
}

__device__ __forceinline__ void spatial_phase(LAS unsigned char* lds, unsigned char* ws, const float* ln_g, const float* ln_b, const float* b_s, int G, int bid, int tid, int lane, int wave) {
    constexpr int VS = 258;
    const bf16_t* UB = WSP(WS_U); const bf16_t* VB = WSP(WS_V); bf16_t* YB = WSP(WS_Y); const bf16_t* WSB = WSP(WS_WSB); const float* LNP = (const float*)(ws + WS_LNP);
    LAS bf16_t* vn = (LAS bf16_t*)lds;
    LAS float* st = (LAS float*)(lds + 66560);
    const int fr = lane & 15, fq = lane >> 4;
    for (int unit = bid; unit < (M / CH) * NG; unit += G) {
        const int c = unit >> 3, gg = unit & 7, pos0 = c * CH, e0 = gg * 256;
        u32x4 rawv[8];
#pragma unroll
        for (int pass = 0; pass < 8; ++pass) rawv[pass] = *(const u32x4*)(VB + tm_off(pos0 + pass * 16 + (tid >> 5), e0 + (tid & 31) * 8, GW));
        if (tid < CH) { const f32x4* p = (const f32x4*)(LNP + (size_t)(pos0 + tid) * 64); float s1 = 0.f, s2 = 0.f;
#pragma unroll
            for (int i = 0; i < 16; ++i) { const f32x4 v = p[i]; s1 += v[0] + v[2]; s2 += v[1] + v[3]; }
            const float mean = s1 * (1.0f / GW), var = fmaxf(s2 * (1.0f / GW) - mean * mean, 0.f);
            st[tid * 2] = mean; st[tid * 2 + 1] = 1.0f / sqrtf(var + LN_EPS); }
        __syncthreads();
        { const int ec = (tid & 31) * 8; const f32x4 g0 = *(const f32x4*)(ln_g + e0 + ec), g1 = *(const f32x4*)(ln_g + e0 + ec + 4), b0 = *(const f32x4*)(ln_b + e0 + ec), b1 = *(const f32x4*)(ln_b + e0 + ec + 4);
#pragma unroll
            for (int pass = 0; pass < 8; ++pass) { const int s = pass * 16 + (tid >> 5);
                const u32x4 raw = rawv[pass]; const float mean = st[s * 2], rstd = st[s * 2 + 1];
                f32x4 a, b;
                a[0] = __uint_as_float(raw.x << 16); a[1] = __uint_as_float(raw.x & 0xffff0000u); a[2] = __uint_as_float(raw.y << 16); a[3] = __uint_as_float(raw.y & 0xffff0000u);
                b[0] = __uint_as_float(raw.z << 16); b[1] = __uint_as_float(raw.z & 0xffff0000u); b[2] = __uint_as_float(raw.w << 16); b[3] = __uint_as_float(raw.w & 0xffff0000u);
                a = (a - mean) * rstd * g0 + b0; b = (b - mean) * rstd * g1 + b1;
                LAS unsigned* dstp = (LAS unsigned*)(vn + s * VS + ec);
                dstp[0] = cvt_pk_bf16(a[0], a[1]); dstp[1] = cvt_pk_bf16(a[2], a[3]); dstp[2] = cvt_pk_bf16(b[0], b[1]); dstp[3] = cvt_pk_bf16(b[2], b[3]); } }
        __syncthreads();
        const int ew = wave * 32;
        bf16x8 af[2][4];
#pragma unroll
        for (int eb = 0; eb < 2; ++eb)
#pragma unroll
            for (int kb = 0; kb < 4; ++kb)
#pragma unroll
                for (int i = 0; i < 8; ++i) af[eb][kb][i] = (short)vn[(32 * kb + 8 * fq + i) * VS + ew + 16 * eb + fr];
#pragma unroll
        for (int tb = 0; tb < 8; ++tb) {
            f32x4 acc0 = (f32x4){0.f, 0.f, 0.f, 0.f}, acc1 = acc0;
            const int t = 16 * tb + fr;
#pragma unroll
            for (int kb = 0; kb < 4; ++kb) if (kb <= tb / 2) {
                const bf16x8 bfr = *(const bf16x8*)(WSB + ((size_t)(gg * CH + t) * CH + 32 * kb + 8 * fq));
                acc0 = __builtin_amdgcn_mfma_f32_16x16x32_bf16(af[0][kb], bfr, acc0, 0, 0, 0);
                acc1 = __builtin_amdgcn_mfma_f32_16x16x32_bf16(af[1][kb], bfr, acc1, 0, 0, 0); }
            const float bias = b_s[gg * CH + t];
#pragma unroll
            for (int eb = 0; eb < 2; ++eb) { const f32x4 a = eb ? acc1 : acc0; const size_t off = (size_t)(pos0 + t) * GW + e0 + ew + 16 * eb + 4 * fq;
                const u32x2 ur = *(const u32x2*)(UB + tm_off(pos0 + t, e0 + ew + 16 * eb + 4 * fq, GW));
                const float u0 = __uint_as_float(ur.x << 16), u1 = __uint_as_float(ur.x & 0xffff0000u), u2 = __uint_as_float(ur.y << 16), u3 = __uint_as_float(ur.y & 0xffff0000u);
                u32x2 w; w.x = cvt_pk_bf16(u0 * (a[0] + bias), u1 * (a[1] + bias)); w.y = cvt_pk_bf16(u2 * (a[2] + bias), u3 * (a[3] + bias));
                *(u32x2*)(YB + tm_off(pos0 + t, e0 + ew + 16 * eb + 4 * fq, GW)) = w; }
        }
        __syncthreads();
    }
}

__device__ __forceinline__ void conv_phase(unsigned char* ws, const float* cw, int G, int bid, int tid) {
    const bf16_t* __restrict__ UB = WSP(WS_U); const bf16_t* __restrict__ VB = WSP(WS_V); bf16_t* __restrict__ YB = WSP(WS_Y);
#pragma unroll 2
    for (int i = bid * 512 + tid; i < M * (D / 8); i += G * 512) { const int t = i >> 8, d = (i & 255) * 8; const size_t off = (size_t)t * D + d;
        const u32x4 z0 = *(const u32x4*)(VB + tm_off(t, d, D)), bg = *(const u32x4*)(UB + tm_off(t, d, D));
        u32x4 z1 = (u32x4){0u, 0u, 0u, 0u}, z2 = z1; if (t >= 1) z1 = *(const u32x4*)(VB + tm_off(t - 1, d, D)); if (t >= 2) z2 = *(const u32x4*)(VB + tm_off(t - 2, d, D));
        float y[8];
#pragma unroll
        for (int j = 0; j < 4; ++j) {
            const f32x2 w0 = *(const f32x2*)(cw + d + 2 * j), w1 = *(const f32x2*)(cw + D + d + 2 * j), w2 = *(const f32x2*)(cw + 2 * D + d + 2 * j);
            const float zl0 = __uint_as_float(z0[j] << 16), zh0 = __uint_as_float(z0[j] & 0xffff0000u), zl1 = __uint_as_float(z1[j] << 16), zh1 = __uint_as_float(z1[j] & 0xffff0000u);
            const float zl2 = __uint_as_float(z2[j] << 16), zh2 = __uint_as_float(z2[j] & 0xffff0000u), bl = __uint_as_float(bg[j] << 16), bh = __uint_as_float(bg[j] & 0xffff0000u);
            y[2 * j] = bl * (w0.x * zl2 + w1.x * zl1 + w2.x * zl0); y[2 * j + 1] = bh * (w0.y * zh2 + w1.y * zh1 + w2.y * zh0); }
        u32x4 w; w.x = cvt_pk_bf16(y[0], y[1]); w.y = cvt_pk_bf16(y[2], y[3]); w.z = cvt_pk_bf16(y[4], y[5]); w.w = cvt_pk_bf16(y[6], y[7]);
        *(u32x4*)(YB + tm_off(t, d, D)) = w; }
}

template <int MA, int LOA, int HIA, int MB = -1, int LOB = 0, int HIB = 0, int MC = -1, int LOC = 0, int HIC = 0>
__device__ __forceinline__ void ffn_up_phase(const Args& args, LAS unsigned char* lds, unsigned char* ws, int q, int G, int bid, int lane, int wave) {
    pg8::Gemm g{WSP(WS_XB), WSP(WS_W13T) + (size_t)q * 2 * FF * D, D, D, D, M / 256, 2 * FF / 256, 1, (long)256 * D, 0, 0, 0, (long)256 * D, 0, 1, 1};
    pg8::StaticOrder S; S.init(M / 256, 2 * FF / 256, 1, G, bid);
    pg8::EpiSwiglu E{WSP(WS_H), (const float*)(ws + WS_PART)};
    pg8::gemm_phase<pg8::EpiSwiglu, true>(lds, g, S, E);
    convert_in_slack<MA, LOA, HIA, MB, LOB, HIB, MC, LOC, HIC>(args, lds, ws, (M / 256) * (2 * FF / 256), G, bid, lane, wave);
    if (PROBE_DUP & 512) convert_in_slack<MA, LOA, HIA, MB, LOB, HIB, MC, LOC, HIC>(args, lds, ws, (M / 256) * (2 * FF / 256), G, bid, lane, wave);
}
__device__ __forceinline__ void resid_phase(LAS unsigned char* lds, unsigned char* ws, const bf16_t* A, const bf16_t* Bt, int K, int btile, const float* base, float* X, float alpha, int G, int bid, bool want_xb = true) {
    pg8::Gemm g{A, Bt, K, K, K, M / 256, D / 256, 1, (long)256 * K, 0, 0, 0, (long)256 * K, 0, btile, 1};
    pg8::StaticOrder S; S.init(M / 256, D / 256, 1, G, bid);
    pg8::EpiResid E{nullptr, WSP(WS_XB), (float*)(ws + WS_PART), alpha, 1.0f / alpha};
    pg8::gemm_phase<pg8::EpiResid, true>(lds, g, S, E);
}

template <int L>
__device__ __forceinline__ void layer_phases(const Args& args, LAS unsigned char* lds, unsigned char* ws, const XcdBarrier& xbar, const float* x_in, float* X, const float* p0, const float* p1, const float* p2, int lo, int hi, int coop, int G, int bid, int tid, int lane, int wave) {
    constexpr int PA = (L == 0) ? 1 : 12, P = 3 + 9 * L;
    if (IN(PA)) { if (PROBE_DUP & 2) ffn_up_phase<-1, 0, 0>(args, lds, ws, L, G, bid, lane, wave);
        if constexpr (L == 0) ffn_up_phase<4, 0, 2816, 12, 0, 2048, 13, 0, 2048>(args, lds, ws, L, G, bid, lane, wave);
        else ffn_up_phase<8, 0, 3072, 5, 0, 2816>(args, lds, ws, L, G, bid, lane, wave);
        SEAM(PA); }
    if (IN(PA + 1)) { resid_phase(lds, ws, WSP(WS_H), WSP(WS_W2T) + (size_t)L * D * FF, FF, 1, L == 0 ? x_in : X, X, 0.5f, G, bid);
        if constexpr (L != 0) SEAM(PA + 1);
    }
    if constexpr (L == 0) {
        if (IN(3)) {
            pg8::Gemm g{WSP(WS_MEMN), WSP(WS_WKVT), D, D, D, 1, 16, 2, 0, 0, (long)MEM * D, 0, (long)256 * D, (long)2 * D * D, 1, 0};
            pg8::StaticOrder S; S.init(1, 16, 2, G, bid);
            pg8::EpiBf16 E{WSP(WS_KV), 2 * D, (long)MEM * 2 * D, 1.0f, nullptr};
            pg8::gemm_phase<pg8::EpiBf16, true>(lds, g, S, E);
            if (PROBE_DUP & 128) pg8::gemm_phase<pg8::EpiBf16, true>(lds, g, S, E);
            convert_in_slack<14, 0, 1024, 15, 0, 1024, 10, 0, 2048>(args, lds, ws, 32, G, bid, lane, wave);
            if (bid >= 32 % G) wqb_convert(args, ws, (bid - 32 % G) * 512 + tid, (G - 32 % G) * 512);
            SEAM(3);
        }
        if (IN(4)) {
            { pg8::Gemm g{WSP(WS_KV), WSP(WS_WQB), 2 * D, D, HD, 4, 8, 2, (long)HD, 0, (long)MEM * 2 * D, (long)HD, (long)256 * D, (long)D * D, 0, 0};
              pg8::EpiBf16 E{WSP(WS_WQKT), D, (long)1024 * D, 0.04419417382415922f, nullptr}; pg8::StaticOrder S; S.init(4, 8, 2, G, bid);
              pg8::gemm_phase<pg8::EpiBf16, true>(lds, g, S, E); }
            { pg8::Gemm g{WSP(WS_WOT), WSP(WS_KV) + D, D, 2 * D, HD, 8, 4, 2, (long)256 * D, (long)HD, (long)D * D, 0, (long)HD, (long)MEM * 2 * D, 0, 0};
              pg8::EpiBf16 E{WSP(WS_VWOT), 1024, (long)D * 1024, 1.0f, nullptr}; pg8::StaticOrder S; S.init(8, 4, 2, G, (bid + G / 2) % G);
              pg8::gemm_phase<pg8::EpiBf16, true>(lds, g, S, E); }
            convert_in_slack<11, 0, 1024, 9, 0, 1024>(args, lds, ws, 64, G, bid, lane, wave);
            __syncthreads();
        }
    }
    if (IN(P + 2)) {
        if constexpr (L == 0) {
            pg8::Gemm g{WSP(WS_XB), WSP(WS_GWIN), D, D, D, M / 256, 16, 1, (long)256 * D, 0, 0, 0, (long)256 * D, 0, 1, 1};
            pg8::StaticOrder S; S.init(M / 256, 16, 1, G, bid);
            pg8::EpiGeluUV E{WSP(WS_U), WSP(WS_V), (const float*)(ws + WS_PART), (float*)(ws + WS_LNP)};
            pg8::gemm_phase<pg8::EpiGeluUV, true>(lds, g, S, E);
            if (PROBE_DUP & 8) pg8::gemm_phase<pg8::EpiGeluUV, true>(lds, g, S, E);
        } else {
            pg8::Gemm g{WSP(WS_XB), WSP(WS_CWIN), D, D, D, M / 256, 24, 1, (long)256 * D, 0, 0, 0, (long)256 * D, 0, 1, 1};
            pg8::StaticOrder S; S.init(M / 256, 24, 1, G, bid);
            pg8::EpiConvIn E{WSP(WS_U), WSP(WS_V), (const float*)(ws + WS_PART)};
            pg8::gemm_phase<pg8::EpiConvIn, true>(lds, g, S, E);
            if (PROBE_DUP & 8) pg8::gemm_phase<pg8::EpiConvIn, true>(lds, g, S, E);
        }
        SEAM(P + 2);
    }
    if (IN(P + 3)) {
        if constexpr (L == 0) spatial_phase(lds, ws, p0, p1, p2, G, bid, tid, lane, wave); else conv_phase(ws, p0, G, bid, tid);
        if (PROBE_DUP & 16) { if constexpr (L == 0) spatial_phase(lds, ws, p0, p1, p2, G, bid, tid, lane, wave); else conv_phase(ws, p0, G, bid, tid); }
        SEAM(P + 3);
    }
    if (IN(P + 4)) { resid_phase(lds, ws, WSP(WS_Y), L == 0 ? WSP(WS_GWOUT) : WSP(WS_CWOUT), D, 1, X, X, 1.0f, G, bid); SEAM(P + 4); }
    if (IN(P + 5)) {
        pg8::Gemm g{WSP(WS_XB), WSP(WS_WQKT) + (size_t)L * 1024 * D, D, D, D, M / 256, NH, 1, (long)256 * D, 0, 0, 0, (long)256 * D, 0, 0, 1};
        pg8::StaticOrder S; S.init(M / 256, NH, 1, G, bid);
        pg8::EpiSoftmax E{WSP(WS_P), (const float*)(ws + WS_PART)};
        pg8::gemm_phase<pg8::EpiSoftmax, false>(lds, g, S, E);
        if constexpr (L == 0) convert_in_slack<2, 0, 5632, 6, 0, 1408>(args, lds, ws, (M / 256) * NH, G, bid, lane, wave);
        else convert_in_slack<3, 0, 5632>(args, lds, ws, (M / 256) * NH, G, bid, lane, wave);
        if (PROBE_DUP & 32) pg8::gemm_phase<pg8::EpiSoftmax, false>(lds, g, S, E);
        SEAM(P + 5);
    }
    if (IN(P + 6)) { resid_phase(lds, ws, WSP(WS_P), WSP(WS_VWOT) + (size_t)L * D * 1024, 1024, 0, X, X, 1.0f, G, bid); SEAM(P + 6); }
    if (IN(P + 7)) { if (PROBE_DUP & 2) ffn_up_phase<-1, 0, 0>(args, lds, ws, 2 + L, G, bid, lane, wave);
        if constexpr (L == 0) ffn_up_phase<1, 0, 5632, 6, 1408, 2816>(args, lds, ws, 2 + L, G, bid, lane, wave);
        else ffn_up_phase<7, 0, 2816>(args, lds, ws, 2 + L, G, bid, lane, wave);
        SEAM(P + 7); }
    if (IN(P + 8)) { resid_phase(lds, ws, WSP(WS_H), WSP(WS_W2T) + (size_t)(2 + L) * D * FF, FF, 1, X, X, 0.5f, G, bid, L == 0);   SEAM(P + 8); }
}

__global__ void __launch_bounds__(512, 2) fwd_megakernel(Args args) {
    extern __shared__ __attribute__((aligned(16))) unsigned char lds_raw[];
    LAS unsigned char* lds = (LAS unsigned char*)lds_raw;
    const int tid = threadIdx.x, lane = tid & 63, wave = __builtin_amdgcn_readfirstlane(tid >> 6);
    const int G = gridDim.x, bid = blockIdx.x;
    unsigned char* ws = args.ws;
    float* X = args.out;
    const int lo = args.ph_lo, hi = args.ph_hi, coop = args.coop;
    volatile LAS unsigned* misc = (volatile LAS unsigned*)(lds + LDS_MISC);
    if (tid < 64) misc[tid] = 0u;
    __syncthreads();
    XcdBarrier xbar; xbar.bar = (unsigned*)(ws + WS_BAR); xbar.x = 0; xbar.st = nullptr;
    if (coop) xbar = xcd_barrier_post((unsigned*)(ws + WS_BAR), misc + 8);

    if (IN(0)) { for (int rep = 0; rep < 1 + (PROBE_DUP & 1); ++rep) prologue_phase(args, lds, ws, G, bid, tid, lane, wave); SEAM(0); }
    layer_phases<0>(args, lds, ws, xbar, args.in[0], X, args.in[7], args.in[8], args.in[10], lo, hi, coop, G, bid, tid, lane, wave);
    layer_phases<1>(args, lds, ws, xbar, args.in[0], X, args.in[13], nullptr, nullptr, lo, hi, coop, G, bid, tid, lane, wave);
    if ((PROBE_DUP & 256) && coop) { for (int rep = 0; rep < 40; ++rep) xcd_barrier(xbar); }
    if (IN(21)) {
        const float* gn = args.in[23]; const float* PART = (const float*)(ws + WS_PART); const bf16_t* XBF = WSP(WS_XB);
        const int gw = bid * 8 + wave, NGW = G * 8;
        for (int m = gw; m < M; m += NGW) {
            u32x4 w[4];
#pragma unroll
            for (int j = 0; j < 4; ++j) w[j] = *(const u32x4*)(XBF + tm_off(m, 512 * j + 8 * lane, D));
            float s = PART[(size_t)m * 32 + (lane & 31)];
            s += __shfl_xor(s, 1); s += __shfl_xor(s, 2); s += __shfl_xor(s, 4); s += __shfl_xor(s, 8); s += __shfl_xor(s, 16);
            const float rs = 1.0f / sqrtf(s * (1.0f / D) + RMS_EPS);
            float* orow = X + (size_t)m * D;
#pragma unroll
            for (int j = 0; j < 4; ++j) { const int c = 512 * j + 8 * lane;
                const f32x4 lo = (f32x4){__uint_as_float(w[j].x << 16), __uint_as_float(w[j].x & 0xffff0000u), __uint_as_float(w[j].y << 16), __uint_as_float(w[j].y & 0xffff0000u)};
                const f32x4 hi = (f32x4){__uint_as_float(w[j].z << 16), __uint_as_float(w[j].z & 0xffff0000u), __uint_as_float(w[j].w << 16), __uint_as_float(w[j].w & 0xffff0000u)};
                *(f32x4*)(orow + c) = lo * rs * *(const f32x4*)(gn + c); *(f32x4*)(orow + c + 4) = hi * rs * *(const f32x4*)(gn + c + 4); }
        }
    }
}

extern "C" void kernel_launch(void* const* d_in, const int* in_sizes, int n_in, void* d_out, int out_size, void* d_ws, size_t ws_size, hipStream_t stream) {
    static int grid = 0;
    if (grid == 0) {
        if (n_in != 24 || out_size != M * D || ws_size < WS_END) { fprintf(stderr, "kernel_launch: unexpected shapes: n_in %d out %d ws %zu (need %zu)\n", n_in, out_size, ws_size, (size_t)WS_END); grid = -1; return; }
        int dev = 0, cus = 0, per_cu = 0;
        hipGetDevice(&dev); hipDeviceGetAttribute(&cus, hipDeviceAttributeMultiprocessorCount, dev);
        if (hipFuncSetAttribute((const void*)fwd_megakernel, hipFuncAttributeMaxDynamicSharedMemorySize, LDS_BYTES) != hipSuccess) { fprintf(stderr, "kernel_launch: hipFuncSetAttribute failed\n"); grid = -1; return; }
        if (hipOccupancyMaxActiveBlocksPerMultiprocessor(&per_cu, (const void*)fwd_megakernel, 512, LDS_BYTES) != hipSuccess || per_cu < 1) { fprintf(stderr, "kernel_launch: occupancy query failed (%d)\n", per_cu); per_cu = 1; }
        (void)hipGetLastError();
        grid = cus * per_cu;
        fprintf(stderr, "kernel_launch: grid %d (cus %d x %d)\n", grid, cus, per_cu);
    }
    if (grid < 0) return;
    Args a{};
    for (int i = 0; i < 24; ++i) a.in[i] = (const float*)d_in[i];
    a.out = (float*)d_out; a.ws = (unsigned char*)d_ws;
#if MK_PER_PHASE
    for (int ph = 0; ph < NPHASE; ++ph) { a.ph_lo = ph; a.ph_hi = ph + 1; a.coop = 0;
        hipLaunchKernelGGL(fwd_megakernel, dim3(grid), dim3(512), LDS_BYTES, stream, a); }
#else
    a.ph_lo = 0; a.ph_hi = NPHASE; a.coop = 1;
    if (hipMemsetAsync((char*)d_ws + WS_BAR, 0, 16384, stream) != hipSuccess) { fprintf(stderr, "kernel_launch: memset of barrier words failed\n"); return; }
    void* kargs[] = {&a};
    hipError_t e = hipLaunchCooperativeKernel((const void*)fwd_megakernel, dim3(grid), dim3(512), kargs, LDS_BYTES, stream);
    if (e != hipSuccess) fprintf(stderr, "kernel_launch: cooperative launch failed: %s (grid %d)\n", hipGetErrorString(e), grid);
#endif
}
```

```cpp
#include <hip/hip_runtime.h>
#include <hip/hip_cooperative_groups.h>
#include <cstdio>
#include <cstdint>
namespace cg = cooperative_groups;

#ifndef PROBE_DUP
#define PROBE_DUP 0
#endif
#ifndef MK_PER_PHASE
#define MK_PER_PHASE 0
#endif

constexpr int M = 8192, D = 2048, FF = 5632, MEM = 256, NH = 4, HD = 512, GW = 2048, NG = 8, CH = 128;
constexpr float RMS_EPS = 1e-6f, LN_EPS = 1e-5f;

#define LAS __attribute__((address_space(3)))
typedef unsigned short bf16_t;
typedef short bf16x8 __attribute__((ext_vector_type(8)));
typedef float f32x4 __attribute__((ext_vector_type(4)));
typedef float f32x2 __attribute__((ext_vector_type(2)));
typedef unsigned u32x4 __attribute__((ext_vector_type(4)));
typedef unsigned u32x2 __attribute__((ext_vector_type(2)));

constexpr size_t al(size_t x) { return (x + 4095) & ~(size_t)4095; }
constexpr size_t SZ_W13T = (size_t)2 * FF * D * 2, SZ_W2T = (size_t)D * FF * 2;
constexpr size_t WS_W13T = 0;
constexpr size_t WS_W2T = WS_W13T + 4 * SZ_W13T;
constexpr size_t WS_GWIN = WS_W2T + 4 * SZ_W2T;
constexpr size_t WS_GWOUT = WS_GWIN + (size_t)2 * GW * D * 2;
constexpr size_t WS_CWIN = WS_GWOUT + (size_t)D * GW * 2;
constexpr size_t WS_CWOUT = WS_CWIN + (size_t)3 * D * D * 2;
constexpr size_t WS_WQB = WS_CWOUT + (size_t)D * D * 2;
constexpr size_t WS_WKVT = WS_WQB + (size_t)2 * D * D * 2;
constexpr size_t WS_WOT = WS_WKVT + (size_t)2 * 2 * D * D * 2;
constexpr size_t WS_WQKT = WS_WOT + (size_t)2 * D * D * 2;
constexpr size_t WS_VWOT = WS_WQKT + (size_t)2 * 1024 * D * 2;
constexpr size_t WS_WSB = WS_VWOT + (size_t)2 * D * 1024 * 2;
constexpr size_t WS_MEMN = WS_WSB + (size_t)NG * CH * CH * 2;
constexpr size_t WS_KV = WS_MEMN + (size_t)2 * MEM * D * 2;
constexpr size_t WS_XB = WS_KV + (size_t)2 * MEM * 2 * D * 2;
constexpr size_t WS_H = WS_XB + (size_t)M * D * 2;
constexpr size_t WS_U = WS_H + (size_t)M * FF * 2;
constexpr size_t WS_V = WS_U + (size_t)M * D * 2;
constexpr size_t WS_Y = WS_V + (size_t)M * D * 2;
constexpr size_t WS_P = WS_Y + (size_t)M * D * 2;
constexpr size_t WS_PART = WS_P + (size_t)M * 1024 * 2;
constexpr size_t WS_LNP = WS_PART + (size_t)M * 32 * 4;
constexpr size_t WS_BAR = WS_LNP + (size_t)M * 64 * 4;
constexpr size_t WS_XT = WS_BAR + 16384;
constexpr size_t WS_END = WS_XT + (size_t)M * D * 4;

constexpr int LDS_MISC = 131072 + 8192, LDS_BYTES = LDS_MISC + 256;

__device__ __forceinline__ size_t tm_off(int r, int k, int K) { return ((size_t)((r >> 8) * (K >> 6) + (k >> 6)) << 14) + (size_t)(((((k >> 5) & 1) << 8) + (r & 255)) << 5) + (k & 31); }

namespace pg8 {
constexpr int BM = 256, BK = 64, HALF = 128, HTB = HALF * BK * 2, STAGE_BYTES = 8 * HTB, NXCD = 8, WGM = 8;
__host__ __device__ __forceinline__ int lds_byte(int r, int c) { const int st = (r >> 4) * 2 + (c >> 5), rr = r & 15, cc = c & 31, ob = rr * 64 + cc * 2; return st * 1024 + (ob ^ (((ob >> 9) & 1) << 5)); }
__host__ __device__ __forceinline__ void stage_rc(int b, int& R, int& C) { const int st = b / 1024, sb = b % 1024, swz = sb ^ (((sb >> 9) & 1) << 5); R = (st >> 1) * 16 + swz / 64; C = (st & 1) * 32 + (swz % 64) / 2; }
__host__ __device__ __forceinline__ int perm32(int rho) { const int n = rho >> 4, i = rho & 15; return 8 * (i >> 2) + 4 * n + (i & 3); }

struct Unit { int pm, pn, z; };
struct Gemm { const bf16_t* A; const bf16_t* Bt; int lda, ldb, K, nM, nN, nZ; long sAm, sAn, sAz, sBm, sBn, sBz; int btile, atile; };

struct StaticOrder {
    int nM, nN, nper, nwg, G, c;
    __device__ __forceinline__ void init(int nM_, int nN_, int nZ_, int G_, int c_) { nM = nM_; nN = nN_; nper = nM * nN; nwg = nper * nZ_; G = G_; c = c_; }
    __device__ __forceinline__ bool next(int i, Unit& u) const {
        const long L = (long)i * G + c; if (L >= nwg) return false;
        int wgid = (int)L; { const int q = nwg / NXCD, r = nwg % NXCD, xcd = wgid % NXCD, off = wgid / NXCD; wgid = (xcd < r ? xcd * (q + 1) : r * (q + 1) + (xcd - r) * q) + off; }
        u.z = wgid / nper; wgid -= u.z * nper;
        const int nig = WGM * nN, gid = wgid / nig, fm = gid * WGM, gsz = (nM - fm) < WGM ? (nM - fm) : WGM;
        u.pm = fm + ((wgid % nig) % gsz); u.pn = (wgid % nig) / gsz; return true;
    }
};

__device__ __forceinline__ unsigned cvt_pk_bf16(float lo, float hi) { unsigned r; asm volatile("v_cvt_pk_bf16_f32 %0, %1, %2" : "=v"(r) : "v"(lo), "v"(hi)); return r; }
__device__ __forceinline__ f32x2 gelu_pk(f32x2 v) {
    const f32x2 av = __builtin_elementwise_abs(v), d = av * 0.2316418882f + 1.0f;
    f32x2 t; t.x = __builtin_amdgcn_rcpf(d.x); t.y = __builtin_amdgcn_rcpf(d.y);
    f32x2 q = t * 0.5307027145f + (-0.7265760135f); q = q * t + 0.7107068705f; q = q * t + (-0.142248368f); q = q * t + 0.127414796f; q = q * t;
    const f32x2 s = (v * v) * (-0.72134752044f);
    f32x2 e; e.x = __builtin_amdgcn_exp2f(s.x); e.y = __builtin_amdgcn_exp2f(s.y);
    const f32x2 m = v * (q * e), r = v - m;
    f32x2 o; o.x = v.x < 0.f ? m.x : r.x; o.y = v.y < 0.f ? m.y : r.y; return o;
}
__device__ __forceinline__ f32x4 gelu4(f32x4 v) { const f32x2 a = gelu_pk((f32x2){v[0], v[1]}), b = gelu_pk((f32x2){v[2], v[3]}); return (f32x4){a.x, a.y, b.x, b.y}; }
__device__ __forceinline__ u32x4 pack8(f32x4 a, f32x4 b) { u32x4 w; w.x = cvt_pk_bf16(a[0], a[1]); w.y = cvt_pk_bf16(a[2], a[3]); w.z = cvt_pk_bf16(b[0], b[1]); w.w = cvt_pk_bf16(b[2], b[3]); return w; }
__device__ __forceinline__ float row_rstd(const float* part, int r) {
    const f32x4* p = (const f32x4*)(part + (size_t)r * 32);
    f32x4 s = p[0];
#pragma unroll
    for (int i = 1; i < 8; ++i) s += p[i];
    const float t = (s[0] + s[1]) + (s[2] + s[3]);
    return 1.0f / sqrtf(t * (1.0f / D) + RMS_EPS);
}
__device__ __forceinline__ float tile_rstd(const LAS float* rst, int ui, int rl, const float* part, int r) { return ui < 8 ? rst[ui * 256 + rl] : row_rstd(part, r); }
__device__ __forceinline__ float silu1(float g) { return g * __builtin_amdgcn_rcpf(1.0f + __builtin_amdgcn_exp2f(g * -1.44269504089f)); }

struct EpiBf16 {
    static constexpr bool PERM = true, AFTER_DRAIN = false, NEEDS_RS = false, ACC_INIT = false;
    bf16_t* C; int ldc; long sCz; float scale; const float* part;
    __device__ __forceinline__ void operator()(const f32x4 (&acc)[2][2][4][2], const Unit& u, int ui, const LAS float* rst, int wr, int wc, int fr, int fq) const {
        bf16_t* base = C + (size_t)u.z * sCz + (size_t)(u.pm * BM + wr * 64 + fr) * ldc + u.pn * BM + wc * 32 + 8 * fq;
#pragma unroll
        for (int ai = 0; ai < 2; ++ai)
#pragma unroll
            for (int m = 0; m < 4; ++m)
#pragma unroll
                for (int bj = 0; bj < 2; ++bj)
                    *(u32x4*)(base + (size_t)(ai * HALF + m * 16) * ldc + bj * HALF) = pack8(acc[ai][bj][m][0] * scale, acc[ai][bj][m][1] * scale);
    }
};
struct EpiSwiglu {
    static constexpr bool PERM = true, AFTER_DRAIN = false, NEEDS_RS = true, ACC_INIT = false;
    bf16_t* H; const float* part;
    __device__ __forceinline__ void operator()(const f32x4 (&acc)[2][2][4][2], const Unit& u, int ui, const LAS float* rst, int wr, int wc, int fr, int fq) const {
        const int row0 = u.pm * BM + wr * 64 + fr, col0 = u.pn * HALF + wc * 32 + 8 * fq;
#pragma unroll
        for (int ai = 0; ai < 2; ++ai)
#pragma unroll
            for (int m = 0; m < 4; ++m) {
                const int r = row0 + ai * HALF + m * 16; const float rs = tile_rstd(rst, ui, r - u.pm * BM, part, r), c2 = rs * -1.44269504089f, rs2 = rs * rs;
                f32x4 h[2];
#pragma unroll
                for (int n = 0; n < 2; ++n) {
                    const f32x4 g = acc[ai][0][m][n], t = g * c2;
                    const f32x4 d = (f32x4){__builtin_amdgcn_exp2f(t[0]), __builtin_amdgcn_exp2f(t[1]), __builtin_amdgcn_exp2f(t[2]), __builtin_amdgcn_exp2f(t[3])} + 1.0f;
                    const f32x4 r = (f32x4){__builtin_amdgcn_rcpf(d[0]), __builtin_amdgcn_rcpf(d[1]), __builtin_amdgcn_rcpf(d[2]), __builtin_amdgcn_rcpf(d[3])};
                    h[n] = ((g * acc[ai][1][m][n]) * r) * rs2; }
                *(u32x4*)(H + tm_off(r, col0, FF)) = pack8(h[0], h[1]);
            }
    }
};
struct EpiResid {
    static constexpr bool PERM = true, AFTER_DRAIN = false, NEEDS_RS = false, ACC_INIT = true;
    const float* base_rm; bf16_t* xb; float* part; float alpha, ialpha;
    __device__ __forceinline__ void init(f32x4 (&acc)[2][2][4][2], const Unit& u, int wr, int wc, int fr, int fq) const {
        const int row0 = u.pm * BM + wr * 64 + fr, col0 = u.pn * BM + wc * 32 + 8 * fq;
#pragma unroll
        for (int ai = 0; ai < 2; ++ai)
#pragma unroll
            for (int m = 0; m < 4; ++m)
#pragma unroll
                for (int bj = 0; bj < 2; ++bj) { const u32x4 w = *(const u32x4*)(xb + tm_off(row0 + ai * HALF + m * 16, col0 + bj * HALF, D));
                    acc[ai][bj][m][0] = (f32x4){__uint_as_float(w.x << 16), __uint_as_float(w.x & 0xffff0000u), __uint_as_float(w.y << 16), __uint_as_float(w.y & 0xffff0000u)} * ialpha;
                    acc[ai][bj][m][1] = (f32x4){__uint_as_float(w.z << 16), __uint_as_float(w.z & 0xffff0000u), __uint_as_float(w.w << 16), __uint_as_float(w.w & 0xffff0000u)} * ialpha; }
    }
    __device__ __forceinline__ void operator()(const f32x4 (&acc)[2][2][4][2], const Unit& u, int ui, const LAS float* rst, int wr, int wc, int fr, int fq) const {
        const int row0 = u.pm * BM + wr * 64 + fr, col0 = u.pn * BM + wc * 32 + 8 * fq;
#pragma unroll
        for (int ai = 0; ai < 2; ++ai)
#pragma unroll
            for (int m = 0; m < 4; ++m) {
                const int r = row0 + ai * HALF + m * 16; float ss = 0.f;
#pragma unroll
                for (int bj = 0; bj < 2; ++bj) {
                    const f32x4 o0 = acc[ai][bj][m][0] * alpha, o1 = acc[ai][bj][m][1] * alpha;
                    *(u32x4*)(xb + tm_off(r, col0 + bj * HALF, D)) = pack8(o0, o1);
                    ss += ((o0[0] * o0[0] + o0[1] * o0[1]) + (o0[2] * o0[2] + o0[3] * o0[3])) + ((o1[0] * o1[0] + o1[1] * o1[1]) + (o1[2] * o1[2] + o1[3] * o1[3])); }
                ss += __shfl_xor(ss, 16); ss += __shfl_xor(ss, 32);
                if (fq == 0) part[(size_t)r * 32 + u.pn * 4 + wc] = ss;
            }
    }
};
struct EpiGeluUV {
    static constexpr bool PERM = true, AFTER_DRAIN = false, NEEDS_RS = true, ACC_INIT = false;
    bf16_t* U; bf16_t* V; const float* part; float* lnp;
    __device__ __forceinline__ void operator()(const f32x4 (&acc)[2][2][4][2], const Unit& u, int ui, const LAS float* rst, int wr, int wc, int fr, int fq) const {
        const bool isv = u.pn >= 8; bf16_t* dst = isv ? V : U;
        const int row0 = u.pm * BM + wr * 64 + fr, col0 = (u.pn & 7) * BM + wc * 32 + 8 * fq;
#pragma unroll
        for (int ai = 0; ai < 2; ++ai)
#pragma unroll
            for (int m = 0; m < 4; ++m) {
                const int r = row0 + ai * HALF + m * 16; const float rs = tile_rstd(rst, ui, r - u.pm * BM, part, r); float s1 = 0.f, s2 = 0.f;
#pragma unroll
                for (int bj = 0; bj < 2; ++bj) { const f32x4 a = gelu4(acc[ai][bj][m][0] * rs), b = gelu4(acc[ai][bj][m][1] * rs);
                    *(u32x4*)(dst + tm_off(r, col0 + bj * HALF, GW)) = pack8(a, b);
                    s1 += ((a[0] + a[1]) + (a[2] + a[3])) + ((b[0] + b[1]) + (b[2] + b[3]));
                    s2 += ((a[0] * a[0] + a[1] * a[1]) + (a[2] * a[2] + a[3] * a[3])) + ((b[0] * b[0] + b[1] * b[1]) + (b[2] * b[2] + b[3] * b[3])); }
                if (isv) { s1 += __shfl_xor(s1, 16); s1 += __shfl_xor(s1, 32); s2 += __shfl_xor(s2, 16); s2 += __shfl_xor(s2, 32);
                    if (fq == 0) *(f32x2*)(lnp + ((size_t)r * 32 + (u.pn - 8) * 4 + wc) * 2) = (f32x2){s1, s2}; }
            }
    }
};
struct EpiConvIn {
    static constexpr bool PERM = true, AFTER_DRAIN = false, NEEDS_RS = true, ACC_INIT = false;
    bf16_t* Bg; bf16_t* Z; const float* part;
    __device__ __forceinline__ void operator()(const f32x4 (&acc)[2][2][4][2], const Unit& u, int ui, const LAS float* rst, int wr, int wc, int fr, int fq) const {
        const int row0 = u.pm * BM + wr * 64 + fr;
#pragma unroll
        for (int ai = 0; ai < 2; ++ai)
#pragma unroll
            for (int m = 0; m < 4; ++m) {
                const int r = row0 + ai * HALF + m * 16; const float rs = tile_rstd(rst, ui, r - u.pm * BM, part, r);
                if (u.pn < 8) {
#pragma unroll
                    for (int bj = 0; bj < 2; ++bj) *(u32x4*)(Bg + tm_off(r, u.pn * BM + bj * HALF + wc * 32 + 8 * fq, D)) = pack8(acc[ai][bj][m][0] * rs, acc[ai][bj][m][1] * rs);
                } else {
                    const float r2 = rs * rs;
                    *(u32x4*)(Z + tm_off(r, (u.pn - 8) * HALF + wc * 32 + 8 * fq, D)) = pack8(acc[ai][0][m][0] * acc[ai][1][m][0] * r2, acc[ai][0][m][1] * acc[ai][1][m][1] * r2);
                }
            }
    }
};
struct EpiSoftmax {
    static constexpr bool PERM = true, AFTER_DRAIN = true, NEEDS_RS = true, ACC_INIT = false;
    bf16_t* P; const float* part;
    __device__ __forceinline__ void fused(f32x4 (&acc)[2][2][4][2], const Unit& u, int ui, const LAS float* rst, int wr, int wc, int fr, int fq, LAS unsigned char* lds, int wid, int lane) const {
        LAS float* red = (LAS float*)lds;
        float sm[2][4];
#pragma unroll
        for (int ai = 0; ai < 2; ++ai)
#pragma unroll
            for (int m = 0; m < 4; ++m) {
                const int rl = ai * HALF + wr * 64 + m * 16 + fr; const float rs = tile_rstd(rst, ui, rl, part, u.pm * BM + rl);
                float mx = -3.0e38f;
#pragma unroll
                for (int bj = 0; bj < 2; ++bj)
#pragma unroll
                    for (int n = 0; n < 2; ++n) { f32x4 v = acc[ai][bj][m][n] * rs; acc[ai][bj][m][n] = v; mx = fmaxf(mx, fmaxf(fmaxf(v[0], v[1]), fmaxf(v[2], v[3]))); }
                mx = fmaxf(mx, __shfl_xor(mx, 16)); mx = fmaxf(mx, __shfl_xor(mx, 32));
                if (fq == 0) red[rl * 4 + wc] = mx;
            }
        __syncthreads();
#pragma unroll
        for (int ai = 0; ai < 2; ++ai)
#pragma unroll
            for (int m = 0; m < 4; ++m) {
                const int rl = ai * HALF + wr * 64 + m * 16 + fr; const f32x4 q = *(const LAS f32x4*)(red + rl * 4);
                const float mx = fmaxf(fmaxf(q[0], q[1]), fmaxf(q[2], q[3])); float s = 0.f;
#pragma unroll
                for (int bj = 0; bj < 2; ++bj)
#pragma unroll
                    for (int n = 0; n < 2; ++n) { f32x4 v = (acc[ai][bj][m][n] - mx) * 1.44269504089f;
                        v = (f32x4){__builtin_amdgcn_exp2f(v[0]), __builtin_amdgcn_exp2f(v[1]), __builtin_amdgcn_exp2f(v[2]), __builtin_amdgcn_exp2f(v[3])};
                        acc[ai][bj][m][n] = v; s += (v[0] + v[1]) + (v[2] + v[3]); }
                s += __shfl_xor(s, 16); s += __shfl_xor(s, 32); sm[ai][m] = s;
            }
        __syncthreads();
#pragma unroll
        for (int ai = 0; ai < 2; ++ai)
#pragma unroll
            for (int m = 0; m < 4; ++m) { const int rl = ai * HALF + wr * 64 + m * 16 + fr; if (fq == 0) red[rl * 4 + wc] = sm[ai][m]; }
        __syncthreads();
#pragma unroll
        for (int ai = 0; ai < 2; ++ai)
#pragma unroll
            for (int m = 0; m < 4; ++m) {
                const int rl = ai * HALF + wr * 64 + m * 16 + fr; const f32x4 q = *(const LAS f32x4*)(red + rl * 4);
                const float inv = 1.0f / ((q[0] + q[1]) + (q[2] + q[3]));
#pragma unroll
                for (int bj = 0; bj < 2; ++bj)
                    *(u32x4*)(P + tm_off(u.pm * BM + rl, u.pn * BM + bj * HALF + wc * 32 + 8 * fq, 1024)) = pack8(acc[ai][bj][m][0] * inv, acc[ai][bj][m][1] * inv);
            }
        __syncthreads();
    }
};

template <class Epi, bool ALIGN_EPI>
__device__ __forceinline__ void gemm_phase(LAS unsigned char* lds, const Gemm g, const StaticOrder& S, const Epi& E) {
    const int tid = threadIdx.x, wid = __builtin_amdgcn_readfirstlane(tid >> 6), lane = tid & 63, wr = wid >> 2, wc = wid & 3, fr = lane & 15, fq = lane >> 4;
    const int nt = g.K / BK;
    unsigned voffA[2], voffB[2];
#pragma unroll
    for (int i = 0; i < 2; ++i) { int R, C; stage_rc(tid * 16 + i * 8192, R, C); const int Rb = Epi::PERM ? ((R & ~31) + perm32(R & 31)) : R;
        voffA[i] = g.atile ? (unsigned)((((C >> 5) * BM + R) * 32) + (C & 31)) * 2u : (unsigned)(R * g.lda + C) * 2u; voffB[i] = g.btile ? (unsigned)((((C >> 5) * BM + Rb) * 32) + (C & 31)) * 2u : (unsigned)(Rb * g.ldb + C) * 2u; }
    const size_t kstepA = g.atile ? (size_t)(BM * BK * 2) : (size_t)(BK * 2), kstepB = g.btile ? (size_t)(BM * BK * 2) : (size_t)(BK * 2);
    const size_t hA = g.atile ? (size_t)(HALF * 32 * 2) : (size_t)HALF * g.lda * 2, hB = g.btile ? (size_t)(HALF * 32 * 2) : (size_t)HALF * g.ldb * 2;
    const unsigned ldsw = (unsigned)wid * 1024u;
    const int aoff = lds_byte(wr * 64 + fr, fq * 8), boff = lds_byte(wc * 32 + fr, fq * 8);
#define PG8_SA(b, h) (((b) * 2 + (h)) * HTB)
#define PG8_SB(b, h) ((4 + (b) * 2 + (h)) * HTB)
#define PG8_STAGE(bufoff, gbase, voff) do { _Pragma("unroll") for (int _i = 0; _i < 2; ++_i) \
        __builtin_amdgcn_global_load_lds((const unsigned*)((const char*)(gbase) + (voff)[_i]), (LAS unsigned*)(lds + (bufoff) + ldsw + _i * 8192), 16, 0, 0); } while (0)
#define PG8_LDA(dst, b, h) do { _Pragma("unroll") for (int m = 0; m < 4; ++m) _Pragma("unroll") for (int k = 0; k < 2; ++k) dst[m][k] = *(const LAS bf16x8*)(lds + PG8_SA(b, h) + aoff + m * 2048 + k * 1024); } while (0)
#define PG8_LDB(dst, b, h) do { _Pragma("unroll") for (int n = 0; n < 2; ++n) _Pragma("unroll") for (int k = 0; k < 2; ++k) dst[n][k] = *(const LAS bf16x8*)(lds + PG8_SB(b, h) + boff + n * 2048 + k * 1024); } while (0)
#define PG8_MMA(ai, bj, At, Bt) do { __builtin_amdgcn_s_setprio(1); _Pragma("unroll") for (int m = 0; m < 4; ++m) _Pragma("unroll") for (int n = 0; n < 2; ++n) _Pragma("unroll") for (int k = 0; k < 2; ++k) \
        acc[ai][bj][m][n] = __builtin_amdgcn_mfma_f32_16x16x32_bf16(Bt[n][k], At[m][k], acc[ai][bj][m][n], 0, 0, 0); __builtin_amdgcn_s_setprio(0); } while (0)
#define PG8_WAIT_V(n) asm volatile("s_waitcnt vmcnt(" #n ")" ::: "memory")
#define PG8_WAIT_L(n) asm volatile("s_waitcnt lgkmcnt(" #n ")" ::: "memory")
#define PG8_BAR __builtin_amdgcn_s_barrier()
#define PG8_SCHED __builtin_amdgcn_sched_barrier(0)
#define PG8_UA(u) ((const char*)g.A + 2 * ((size_t)(u).z * g.sAz + (size_t)(u).pm * g.sAm + (size_t)(u).pn * g.sAn))
#define PG8_UB(u) ((const char*)g.Bt + 2 * ((size_t)(u).z * g.sBz + (size_t)(u).pm * g.sBm + (size_t)(u).pn * g.sBn))
    Unit cur, nxt; int ui = 0;
    if (!S.next(0, cur)) return;
    const LAS float* rst = (const LAS float*)(lds + STAGE_BYTES);
    f32x4 acc[2][2][4][2];
    if constexpr (Epi::ACC_INIT) E.init(acc, cur, wr, wc, fr, fq);
    else {
#pragma unroll
    for (int a = 0; a < 2; ++a)
#pragma unroll
        for (int b = 0; b < 2; ++b)
#pragma unroll
            for (int m = 0; m < 4; ++m)
#pragma unroll
                for (int n = 0; n < 2; ++n) acc[a][b][m][n] = (f32x4){0.f, 0.f, 0.f, 0.f};
    }
    bf16x8 At[4][2], B0[2][2], B1[2][2];
    const char* cA = PG8_UA(cur); const char* cB = PG8_UB(cur);
    PG8_STAGE(PG8_SB(0, 0), cB, voffB); PG8_STAGE(PG8_SB(0, 1), cB + hB, voffB); PG8_STAGE(PG8_SA(0, 0), cA, voffA); PG8_STAGE(PG8_SA(0, 1), cA + hA, voffA);
    if constexpr (Epi::NEEDS_RS) {
        for (int i0 = tid >> 8; i0 < 8; i0 += 6) {
            Unit t0, t1, t2; const bool v0 = S.next(i0, t0), v1 = v0 && (i0 + 2 < 8) && S.next(i0 + 2, t1), v2 = v1 && (i0 + 4 < 8) && S.next(i0 + 4, t2);
            if (!v0) break;
            const int rr = tid & 255; f32x4 a[8], b[8], c[8];
            { const f32x4* p = (const f32x4*)(E.part + (size_t)(t0.pm * BM + rr) * 32);
#pragma unroll
              for (int k = 0; k < 8; ++k) a[k] = p[k]; }
            if (v1) { const f32x4* p = (const f32x4*)(E.part + (size_t)(t1.pm * BM + rr) * 32);
#pragma unroll
              for (int k = 0; k < 8; ++k) b[k] = p[k]; }
            if (v2) { const f32x4* p = (const f32x4*)(E.part + (size_t)(t2.pm * BM + rr) * 32);
#pragma unroll
              for (int k = 0; k < 8; ++k) c[k] = p[k]; }
            LAS float* tab = (LAS float*)(lds + STAGE_BYTES);
            { f32x4 s = a[0];
#pragma unroll
              for (int k = 1; k < 8; ++k) s += a[k];
              tab[i0 * 256 + rr] = 1.0f / sqrtf(((s[0] + s[1]) + (s[2] + s[3])) * (1.0f / D) + RMS_EPS); }
            if (v1) { f32x4 s = b[0];
#pragma unroll
              for (int k = 1; k < 8; ++k) s += b[k];
              tab[(i0 + 2) * 256 + rr] = 1.0f / sqrtf(((s[0] + s[1]) + (s[2] + s[3])) * (1.0f / D) + RMS_EPS); }
            if (v2) { f32x4 s = c[0];
#pragma unroll
              for (int k = 1; k < 8; ++k) s += c[k];
              tab[(i0 + 4) * 256 + rr] = 1.0f / sqrtf(((s[0] + s[1]) + (s[2] + s[3])) * (1.0f / D) + RMS_EPS); }
        }
    }
    if (wr == 1) PG8_BAR;
    PG8_WAIT_V(2); PG8_BAR;
    PG8_STAGE(PG8_SB(1, 0), cB + kstepB, voffB); PG8_STAGE(PG8_SA(1, 0), cA + kstepA, voffA); PG8_STAGE(PG8_SB(1, 1), cB + hB + kstepB, voffB);
    PG8_WAIT_V(6); PG8_BAR;
    for (;;) {
        const bool has_next = S.next(ui + 1, nxt);
        const char* nA = has_next ? PG8_UA(nxt) : cA; const char* nB = has_next ? PG8_UB(nxt) : cB;
        for (int t = 0; t < nt; t += 2) {
            const bool last = (t == nt - 2);
            const char* a1 = cA + (size_t)(t + 1) * kstepA;
            const char* a2 = last ? nA : cA + (size_t)(t + 2) * kstepA; const char* b2 = last ? nB : cB + (size_t)(t + 2) * kstepB;
            const char* a3 = a2 + kstepA; const char* b3 = b2 + kstepB;
            PG8_LDB(B0, 0, 0); PG8_LDB(B1, 0, 1); PG8_SCHED; PG8_LDA(At, 0, 0); PG8_STAGE(PG8_SA(1, 1), a1 + hA, voffA);
            PG8_WAIT_V(8); PG8_WAIT_L(0); PG8_BAR; PG8_MMA(0, 0, At, B0); PG8_MMA(0, 1, At, B1); PG8_BAR; PG8_SCHED;
            PG8_LDA(At, 0, 1); PG8_STAGE(PG8_SB(0, 0), b2, voffB); PG8_STAGE(PG8_SB(0, 1), b2 + hB, voffB); PG8_STAGE(PG8_SA(0, 0), a2, voffA);
            PG8_WAIT_V(8); PG8_WAIT_L(0); PG8_BAR; PG8_MMA(1, 0, At, B0); PG8_MMA(1, 1, At, B1); PG8_BAR; PG8_SCHED;
            PG8_LDB(B0, 1, 0); PG8_LDB(B1, 1, 1); PG8_SCHED; PG8_LDA(At, 1, 0); PG8_STAGE(PG8_SA(0, 1), a2 + hA, voffA);
            PG8_WAIT_V(8); PG8_WAIT_L(0); PG8_BAR; PG8_MMA(0, 0, At, B0); PG8_MMA(0, 1, At, B1); PG8_BAR; PG8_SCHED;
            PG8_LDA(At, 1, 1); PG8_STAGE(PG8_SB(1, 0), b3, voffB); PG8_STAGE(PG8_SB(1, 1), b3 + hB, voffB); PG8_STAGE(PG8_SA(1, 0), a3, voffA);
            PG8_WAIT_V(8); PG8_WAIT_L(0); PG8_BAR; PG8_MMA(1, 0, At, B0); PG8_MMA(1, 1, At, B1); PG8_BAR; PG8_SCHED;
        }
        if constexpr (ALIGN_EPI) { if (wr == 0) PG8_BAR; }
        if constexpr (!Epi::AFTER_DRAIN) { E(acc, cur, ui, rst, wr, wc, fr, fq); }
        if (!has_next) break;
        cur = nxt; cA = nA; cB = nB; ++ui;
        if constexpr (Epi::ACC_INIT) E.init(acc, cur, wr, wc, fr, fq);
        else {
#pragma unroll
        for (int a = 0; a < 2; ++a)
#pragma unroll
            for (int b = 0; b < 2; ++b)
#pragma unroll
                for (int m = 0; m < 4; ++m)
#pragma unroll
                    for (int n = 0; n < 2; ++n) acc[a][b][m][n] = (f32x4){0.f, 0.f, 0.f, 0.f};
        }
        if constexpr (ALIGN_EPI) { if (wr == 1) PG8_BAR; }
    }
    PG8_WAIT_V(0);
    if constexpr (!ALIGN_EPI) { if (wr == 0) PG8_BAR; }
    PG8_BAR;
    if constexpr (Epi::AFTER_DRAIN) { E.fused(acc, cur, ui, rst, wr, wc, fr, fq, lds, wid, lane); }
#undef PG8_SA
#undef PG8_SB
#undef PG8_STAGE
#undef PG8_LDA
#undef PG8_LDB
#undef PG8_MMA
#undef PG8_WAIT_V
#undef PG8_WAIT_L
#undef PG8_BAR
#undef PG8_SCHED
#undef PG8_UA
#undef PG8_UB
}
}
using pg8::cvt_pk_bf16;

__device__ __forceinline__ float wave_sum(float v) {
#pragma unroll
    for (int o = 1; o < 64; o <<= 1) v += __shfl_xor(v, o);
    return v;
}
constexpr int TR_LDS_PER_WAVE = 64 * 144;
__device__ __forceinline__ void transpose_item(const float* W, int K, int N, bf16_t* WT, const float* gain, int mode, bool tiled, int item, int lane, LAS unsigned char* scr) {
    const int nblk = N / 64, kb = item / nblk, nb = item % nblk, k0 = 64 * kb, n0 = 64 * nb;
    const float* src = W + (size_t)k0 * N + n0 + lane;
    float v[64];
#pragma unroll
    for (int i = 0; i < 64; ++i) v[i] = __builtin_nontemporal_load(src + (size_t)i * N);
    if (gain) {
#pragma unroll
        for (int i = 0; i < 64; ++i) v[i] *= gain[k0 + i];
    }
    int d0 = n0;
    if (mode == 1) { if (n0 < FF) d0 = (n0 >> 7) * 256 + (n0 & 127); else { const int q = n0 - FF; d0 = (q >> 7) * 256 + 128 + (q & 127); } }
    else if (mode == 2) { if (n0 >= 2 * D) { const int q = n0 - 2 * D; d0 = D + (q >> 7) * 256 + 128 + (q & 127); } else if (n0 >= D) { const int q = n0 - D; d0 = D + (q >> 7) * 256 + (q & 127); } }
    LAS unsigned char* sw = scr + lane * 144;
#pragma unroll
    for (int j = 0; j < 8; ++j) { u32x4 o; o.x = cvt_pk_bf16(v[8 * j], v[8 * j + 1]); o.y = cvt_pk_bf16(v[8 * j + 2], v[8 * j + 3]); o.z = cvt_pk_bf16(v[8 * j + 4], v[8 * j + 5]); o.w = cvt_pk_bf16(v[8 * j + 6], v[8 * j + 7]);
        *(LAS u32x4*)(sw + 16 * j) = o; }
    asm volatile("s_waitcnt lgkmcnt(0)" ::: "memory");
    const int a = lane >> 3, b = lane & 7;
    bf16_t* dst = tiled ? WT + (size_t)((d0 >> 8) * (K / 64) + kb) * (256 * 64) + ((size_t)((b >> 2) * 256 + (d0 & 255) + a) * 32 + 8 * (b & 3)) : WT + (size_t)(d0 + a) * K + k0 + 8 * b;
    const size_t rstep = tiled ? (size_t)8 * 32 : (size_t)8 * K;
#pragma unroll
    for (int s = 0; s < 8; ++s) { const u32x4 c = *(const LAS u32x4*)(scr + (8 * s + a) * 144 + 16 * b); *(u32x4*)(dst + s * rstep) = c; }
    asm volatile("s_waitcnt lgkmcnt(0)" ::: "memory");
}

#define XB_TMO      128
#define XB_XCNT(j)  (256  + 64 * (j))
#define XB_XSUB(j)  (1280 + 64 * (j))
#define XB_XGEN(j)  (2304 + 64 * (j))
#define XB_TOP      3328
#define XB_TOPGEN   3392
#define XCD_BAR_WORDS 3456
#define XB_SPIN_CAP (1u << 18)

__device__ __forceinline__ unsigned xb_ld(unsigned* p)              { return __hip_atomic_load(p, __ATOMIC_RELAXED, __HIP_MEMORY_SCOPE_AGENT); }
__device__ __forceinline__ unsigned xb_add(unsigned* p, unsigned v) { return __hip_atomic_fetch_add(p, v, __ATOMIC_RELAXED, __HIP_MEMORY_SCOPE_AGENT); }
__device__ __forceinline__ unsigned xb_xcc_id() { return (unsigned)__builtin_amdgcn_s_getreg((3 << 11) | 20) & 0xFu; }
#define XB_SPIN(cond, bar) do { unsigned _sp = 0; while (cond) { __builtin_amdgcn_s_sleep(1); \
    if ((++_sp & 255u) == 0u) { if (xb_ld(&(bar)[XB_TMO])) break; if (_sp > XB_SPIN_CAP) { atomicAdd(&(bar)[XB_TMO], 1u); break; } } } } while (0)

struct XcdBarrier {
    unsigned* bar; unsigned x;
    volatile LAS unsigned* st;
};

__device__ __forceinline__ XcdBarrier xcd_barrier_post(unsigned* bar, volatile LAS unsigned* st) {
    XcdBarrier b; b.bar = bar; b.x = xb_xcc_id(); b.st = st;
    if (threadIdx.x == 0) (void)xb_add(&bar[XB_XCNT(b.x)], 1u);
    return b;
}
__device__ __forceinline__ void xcd_barrier_complete(unsigned* bar, unsigned x, unsigned& nloc, unsigned& nx) {
    const unsigned G = gridDim.x * gridDim.y * gridDim.z;
    unsigned sum, cnt, mine, sp = 0u;
    for (;;) {
        sum = 0u; cnt = 0u; mine = 0u;
#pragma unroll
        for (unsigned j = 0; j < 16; ++j) { const unsigned c = xb_ld(&bar[XB_XCNT(j)]); sum += c; cnt += (c > 0u) ? 1u : 0u; mine = (j == x) ? c : mine; }
        if (sum == G) break;
        __builtin_amdgcn_s_sleep(1);
        if ((++sp & 255u) == 0u) { if (xb_ld(&bar[XB_TMO])) break; if (sp > XB_SPIN_CAP) { atomicAdd(&bar[XB_TMO], 1u); break; } }
    }
    nloc = mine > 0u ? mine : 1u; nx = cnt > 0u ? cnt : 1u;
}

__device__ __forceinline__ void xcd_barrier(const XcdBarrier& b) {
    asm volatile("s_waitcnt vmcnt(0)" ::: "memory");
    __syncthreads();
    if (threadIdx.x == 0) {
        unsigned* bar = b.bar;
        __builtin_amdgcn_s_waitcnt(0);
        unsigned nloc = b.st[0], nx = b.st[1];
        if (nloc == 0u) { xcd_barrier_complete(bar, b.x, nloc, nx); b.st[0] = nloc; b.st[1] = nx; }
        const unsigned old = xb_add(&bar[XB_XSUB(b.x)], 1u);
        const unsigned gen = old / nloc;
        if (old + 1u == (gen + 1u) * nloc) {
            __builtin_amdgcn_fence(__ATOMIC_RELEASE, "agent");
            asm volatile("s_waitcnt vmcnt(0)" ::: "memory");
            const unsigned og = xb_add(&bar[XB_TOP], 1u);
            const unsigned tg = og / nx;
            if (og + 1u == (tg + 1u) * nx) xb_add(&bar[XB_TOPGEN], 1u);
            else XB_SPIN(xb_ld(&bar[XB_TOPGEN]) == tg, bar);
            __builtin_amdgcn_fence(__ATOMIC_ACQUIRE, "agent");
            xb_add(&bar[XB_XGEN(b.x)], 1u);
            asm volatile("s_waitcnt vmcnt(0)" ::: "memory");
        } else {
            XB_SPIN(xb_ld(&bar[XB_XGEN(b.x)]) == gen, bar);
            __builtin_amdgcn_fence(__ATOMIC_ACQUIRE, "agent");
            asm volatile("s_waitcnt vmcnt(0)" ::: "memory");
        }
    }
    __syncthreads();
}


struct Args { const float* in[24]; float* out; unsigned char* ws; int ph_lo, ph_hi, coop, pad; };

constexpr int NPHASE = 22;
#define WSP(off) ((bf16_t*)(ws + (off)))
#define IN(k) (lo <= (k) && (k) < hi)
#define SEAM(k) do { if ((k) + 1 < hi && coop) { if (coop == 2) cg::this_grid().sync(); else xcd_barrier(xbar); } } while (0)

template <int MID>
__device__ __forceinline__ void job_setup(const Args& args, unsigned char* ws, const float*& W, int& K, int& N, int& mode, bf16_t*& WT, const float*& gain, bool& tiled) {
    gain = nullptr; mode = 0; tiled = true;
    if constexpr (MID < 4) { constexpr int f = MID >> 1, ll = MID & 1; W = (f ? args.in[21] : args.in[3]) + (size_t)ll * D * 2 * FF; K = D; N = 2 * FF; WT = WSP(WS_W13T) + (size_t)MID * 2 * FF * D; gain = (f ? args.in[20] : args.in[2]) + ll * D; mode = 1; }
    else if constexpr (MID < 8) { constexpr int q = MID - 4, f = q >> 1, ll = q & 1; W = (f ? args.in[22] : args.in[4]) + (size_t)ll * FF * D; K = FF; N = D; WT = WSP(WS_W2T) + (size_t)q * D * FF; }
    else if constexpr (MID == 8) { W = args.in[12]; K = D; N = 3 * D; WT = WSP(WS_CWIN); gain = args.in[5] + D; mode = 2; }
    else if constexpr (MID == 9) { W = args.in[14]; K = D; N = D; WT = WSP(WS_CWOUT); }
    else if constexpr (MID == 10) { W = args.in[6]; K = D; N = 2 * GW; WT = WSP(WS_GWIN); gain = args.in[5]; }
    else if constexpr (MID == 11) { W = args.in[11]; K = GW; N = D; WT = WSP(WS_GWOUT); }
    else if constexpr (MID < 14) { constexpr int ll = MID - 12; W = args.in[18] + (size_t)ll * D * 2 * D; K = D; N = 2 * D; WT = WSP(WS_WKVT) + (size_t)ll * 2 * D * D; }
    else { constexpr int ll = MID - 14; W = args.in[19] + (size_t)ll * D * D; K = D; N = D; WT = WSP(WS_WOT) + (size_t)ll * D * D; tiled = false; }
}
template <int MA, int LOA, int HIA, int MB = -1, int LOB = 0, int HIB = 0, int MC = -1, int LOC = 0, int HIC = 0>
__device__ __forceinline__ void convert_jobs(const Args& args, unsigned char* ws, int gw, int NGW, int lane, LAS unsigned char* scr) {
    constexpr int NA = HIA - LOA, NB = MB >= 0 ? HIB - LOB : 0, NC = MC >= 0 ? HIC - LOC : 0;
    for (int it = gw; it < NA + NB + NC; it += NGW) {
        const float* W; int K, N, mode; bf16_t* WT; const float* gain; bool tiled; int r;
        if (it < NA) { r = LOA + it; job_setup<MA>(args, ws, W, K, N, mode, WT, gain, tiled); }
        else if (it < NA + NB) { r = LOB + it - NA; job_setup<(MB >= 0 ? MB : MA)>(args, ws, W, K, N, mode, WT, gain, tiled); }
        else { r = LOC + it - NA - NB; job_setup<(MC >= 0 ? MC : MA)>(args, ws, W, K, N, mode, WT, gain, tiled); }
        transpose_item(W, K, N, WT, gain, mode, tiled, r, lane, scr);
    }
}
template <int MA, int LOA, int HIA, int MB = -1, int LOB = 0, int HIB = 0, int MC = -1, int LOC = 0, int HIC = 0>
__device__ __forceinline__ void convert_in_slack(const Args& args, LAS unsigned char* lds, unsigned char* ws, int nwg, int G, int bid, int lane, int wave) {
    if constexpr (MA >= 0) {
        const int fs = nwg % G;
        if (bid >= fs) convert_jobs<MA, LOA, HIA, MB, LOB, HIB, MC, LOC, HIC>(args, ws, (bid - fs) * 8 + wave, (G - fs) * 8, lane, lds + wave * TR_LDS_PER_WAVE);
    }
}
__device__ __forceinline__ void wqb_convert(const Args& args, unsigned char* ws, int gt, int NT) {
    bf16_t* WQB = WSP(WS_WQB);
    for (int i = gt; i < 2 * D * D / 8; i += NT) { const size_t e = (size_t)i * 8; const int row = (int)(e / D);
        const float gn = args.in[15][row]; const f32x4 a = *(const f32x4*)(args.in[17] + e) * gn, b = *(const f32x4*)(args.in[17] + e + 4) * gn;
        *(u32x4*)(WQB + e) = pg8::pack8(a, b); }
}

__device__ __forceinline__ void prologue_phase(const Args& args, LAS unsigned char* lds, unsigned char* ws, int G, int bid, int tid, int lane, int wave) {
    bf16_t* XB = WSP(WS_XB); bf16_t* MEMN = WSP(WS_MEMN); bf16_t* WSB = WSP(WS_WSB);
    float* PART = (float*)(ws + WS_PART);
    const int gw = bid * 8 + wave, NGW = G * 8;
    convert_jobs<0, 0, 5632>(args, ws, gw, NGW, lane, lds + wave * TR_LDS_PER_WAVE);
    const int gt = bid * 512 + tid, NT = G * 512;
    for (int i = gt; i < NG * CH * CH / 8; i += NT) { const int e = i * 8, s0 = e & 127, t = (e >> 7) & 127;
        f32x4 a = *(const f32x4*)(args.in[9] + e), b = *(const f32x4*)(args.in[9] + e + 4);
#pragma unroll
        for (int j = 0; j < 4; ++j) { if (s0 + j > t) a[j] = 0.f; if (s0 + 4 + j > t) b[j] = 0.f; }
        *(u32x4*)(WSB + e) = pg8::pack8(a, b); }
    const float* x_in = args.in[0];
    for (int m = gw; m < M; m += NGW) {
        const float* xr = x_in + (size_t)m * D + 8 * lane; float s = 0.f;
#pragma unroll
        for (int j = 0; j < 4; ++j) { const f32x4 a = *(const f32x4*)(xr + 512 * j), b = *(const f32x4*)(xr + 512 * j + 4);
            s += ((a[0] * a[0] + a[1] * a[1]) + (a[2] * a[2] + a[3] * a[3])) + ((b[0] * b[0] + b[1] * b[1]) + (b[2] * b[2] + b[3] * b[3]));
            *(u32x4*)(XB + tm_off(m, 512 * j + 8 * lane, D)) = pg8::pack8(a, b); }
        s = wave_sum(s);
        if (lane < 32) PART[(size_t)m * 32 + lane] = lane == 0 ? s : 0.f;
    }
    for (int m = gw; m < 2 * MEM; m += NGW) { const int ll = m / MEM, row = m % MEM;
        const f32x4* xr = (const f32x4*)(args.in[1] + (size_t)row * D) + lane; const f32x4* gr = (const f32x4*)(args.in[16] + ll * D) + lane; float s = 0.f; f32x4 v[8];
#pragma unroll
        for (int j = 0; j < 8; ++j) { v[j] = xr[64 * j]; s += (v[j][0] * v[j][0] + v[j][1] * v[j][1]) + (v[j][2] * v[j][2] + v[j][3] * v[j][3]); }
        const float rs = 1.0f / sqrtf(wave_sum(s) * (1.0f / D) + RMS_EPS);
#pragma unroll
        for (int j = 0; j < 8; ++j) { const f32x4 o = v[j] * rs * gr[64 * j]; u32x2 w; w.x = cvt_pk_bf16(o[0], o[1]); w.y = cvt_pk_bf16(o[2], o[3]); *((u32x2*)(MEMN + (size_t)m * D) + lane + 64 * j) = w; }
    }
    __syncthreads();
}

__device__ __forceinline__ void spatial_phase(LAS unsigned char* lds, unsigned char* ws, const float* ln_g, const float* ln_b, const float* b_s, int G, int bid, int tid, int lane, int wave) {
    constexpr int VS = 258;
    const bf16_t* UB = WSP(WS_U); const bf16_t* VB = WSP(WS_V); bf16_t* YB = WSP(WS_Y); const bf16_t* WSB = WSP(WS_WSB); const float* LNP = (const float*)(ws + WS_LNP);
    LAS bf16_t* vn = (LAS bf16_t*)lds;
    LAS float* st = (LAS float*)(lds + 66560);
    const int fr = lane & 15, fq = lane >> 4;
    for (int unit = bid; unit < (M / CH) * NG; unit += G) {
        const int c = unit >> 3, gg = unit & 7, pos0 = c * CH, e0 = gg * 256;
        u32x4 rawv[8];
#pragma unroll
        for (int pass = 0; pass < 8; ++pass) rawv[pass] = *(const u32x4*)(VB + tm_off(pos0 + pass * 16 + (tid >> 5), e0 + (tid & 31) * 8, GW));
        if (tid < CH) { const f32x4* p = (const f32x4*)(LNP + (size_t)(pos0 + tid) * 64); float s1 = 0.f, s2 = 0.f;
#pragma unroll
            for (int i = 0; i < 16; ++i) { const f32x4 v = p[i]; s1 += v[0] + v[2]; s2 += v[1] + v[3]; }
            const float mean = s1 * (1.0f / GW), var = fmaxf(s2 * (1.0f / GW) - mean * mean, 0.f);
            st[tid * 2] = mean; st[tid * 2 + 1] = 1.0f / sqrtf(var + LN_EPS); }
        __syncthreads();
        { const int ec = (tid & 31) * 8; const f32x4 g0 = *(const f32x4*)(ln_g + e0 + ec), g1 = *(const f32x4*)(ln_g + e0 + ec + 4), b0 = *(const f32x4*)(ln_b + e0 + ec), b1 = *(const f32x4*)(ln_b + e0 + ec + 4);
#pragma unroll
            for (int pass = 0; pass < 8; ++pass) { const int s = pass * 16 + (tid >> 5);
                const u32x4 raw = rawv[pass]; const float mean = st[s * 2], rstd = st[s * 2 + 1];
                f32x4 a, b;
                a[0] = __uint_as_float(raw.x << 16); a[1] = __uint_as_float(raw.x & 0xffff0000u); a[2] = __uint_as_float(raw.y << 16); a[3] = __uint_as_float(raw.y & 0xffff0000u);
                b[0] = __uint_as_float(raw.z << 16); b[1] = __uint_as_float(raw.z & 0xffff0000u); b[2] = __uint_as_float(raw.w << 16); b[3] = __uint_as_float(raw.w & 0xffff0000u);
                a = (a - mean) * rstd * g0 + b0; b = (b - mean) * rstd * g1 + b1;
                LAS unsigned* dstp = (LAS unsigned*)(vn + s * VS + ec);
                dstp[0] = cvt_pk_bf16(a[0], a[1]); dstp[1] = cvt_pk_bf16(a[2], a[3]); dstp[2] = cvt_pk_bf16(b[0], b[1]); dstp[3] = cvt_pk_bf16(b[2], b[3]); } }
        __syncthreads();
        const int ew = wave * 32;
        bf16x8 af[2][4];
#pragma unroll
        for (int eb = 0; eb < 2; ++eb)
#pragma unroll
            for (int kb = 0; kb < 4; ++kb)
#pragma unroll
                for (int i = 0; i < 8; ++i) af[eb][kb][i] = (short)vn[(32 * kb + 8 * fq + i) * VS + ew + 16 * eb + fr];
#pragma unroll
        for (int tb = 0; tb < 8; ++tb) {
            f32x4 acc0 = (f32x4){0.f, 0.f, 0.f, 0.f}, acc1 = acc0;
            const int t = 16 * tb + fr;
#pragma unroll
            for (int kb = 0; kb < 4; ++kb) if (kb <= tb / 2) {
                const bf16x8 bfr = *(const bf16x8*)(WSB + ((size_t)(gg * CH + t) * CH + 32 * kb + 8 * fq));
                acc0 = __builtin_amdgcn_mfma_f32_16x16x32_bf16(af[0][kb], bfr, acc0, 0, 0, 0);
                acc1 = __builtin_amdgcn_mfma_f32_16x16x32_bf16(af[1][kb], bfr, acc1, 0, 0, 0); }
            const float bias = b_s[gg * CH + t];
#pragma unroll
            for (int eb = 0; eb < 2; ++eb) { const f32x4 a = eb ? acc1 : acc0; const size_t off = (size_t)(pos0 + t) * GW + e0 + ew + 16 * eb + 4 * fq;
                const u32x2 ur = *(const u32x2*)(UB + tm_off(pos0 + t, e0 + ew + 16 * eb + 4 * fq, GW));
                const float u0 = __uint_as_float(ur.x << 16), u1 = __uint_as_float(ur.x & 0xffff0000u), u2 = __uint_as_float(ur.y << 16), u3 = __uint_as_float(ur.y & 0xffff0000u);
                u32x2 w; w.x = cvt_pk_bf16(u0 * (a[0] + bias), u1 * (a[1] + bias)); w.y = cvt_pk_bf16(u2 * (a[2] + bias), u3 * (a[3] + bias));
                *(u32x2*)(YB + tm_off(pos0 + t, e0 + ew + 16 * eb + 4 * fq, GW)) = w; }
        }
        __syncthreads();
    }
}

__device__ __forceinline__ void conv_phase(unsigned char* ws, const float* cw, int G, int bid, int tid) {
    const bf16_t* __restrict__ UB = WSP(WS_U); const bf16_t* __restrict__ VB = WSP(WS_V); bf16_t* __restrict__ YB = WSP(WS_Y);
#pragma unroll 2
    for (int i = bid * 512 + tid; i < M * (D / 8); i += G * 512) { const int t = i >> 8, d = (i & 255) * 8; const size_t off = (size_t)t * D + d;
        const u32x4 z0 = *(const u32x4*)(VB + tm_off(t, d, D)), bg = *(const u32x4*)(UB + tm_off(t, d, D));
        u32x4 z1 = (u32x4){0u, 0u, 0u, 0u}, z2 = z1; if (t >= 1) z1 = *(const u32x4*)(VB + tm_off(t - 1, d, D)); if (t >= 2) z2 = *(const u32x4*)(VB + tm_off(t - 2, d, D));
        float y[8];
#pragma unroll
        for (int j = 0; j < 4; ++j) {
            const f32x2 w0 = *(const f32x2*)(cw + d + 2 * j), w1 = *(const f32x2*)(cw + D + d + 2 * j), w2 = *(const f32x2*)(cw + 2 * D + d + 2 * j);
            const float zl0 = __uint_as_float(z0[j] << 16), zh0 = __uint_as_float(z0[j] & 0xffff0000u), zl1 = __uint_as_float(z1[j] << 16), zh1 = __uint_as_float(z1[j] & 0xffff0000u);
            const float zl2 = __uint_as_float(z2[j] << 16), zh2 = __uint_as_float(z2[j] & 0xffff0000u), bl = __uint_as_float(bg[j] << 16), bh = __uint_as_float(bg[j] & 0xffff0000u);
            y[2 * j] = bl * (w0.x * zl2 + w1.x * zl1 + w2.x * zl0); y[2 * j + 1] = bh * (w0.y * zh2 + w1.y * zh1 + w2.y * zh0); }
        u32x4 w; w.x = cvt_pk_bf16(y[0], y[1]); w.y = cvt_pk_bf16(y[2], y[3]); w.z = cvt_pk_bf16(y[4], y[5]); w.w = cvt_pk_bf16(y[6], y[7]);
        *(u32x4*)(YB + tm_off(t, d, D)) = w; }
}

template <int MA, int LOA, int HIA, int MB = -1, int LOB = 0, int HIB = 0, int MC = -1, int LOC = 0, int HIC = 0>
__device__ __forceinline__ void ffn_up_phase(const Args& args, LAS unsigned char* lds, unsigned char* ws, int q, int G, int bid, int lane, int wave) {
    pg8::Gemm g{WSP(WS_XB), WSP(WS_W13T) + (size_t)q * 2 * FF * D, D, D, D, M / 256, 2 * FF / 256, 1, (long)256 * D, 0, 0, 0, (long)256 * D, 0, 1, 1};
    pg8::StaticOrder S; S.init(M / 256, 2 * FF / 256, 1, G, bid);
    pg8::EpiSwiglu E{WSP(WS_H), (const float*)(ws + WS_PART)};
    pg8::gemm_phase<pg8::EpiSwiglu, true>(lds, g, S, E);
    convert_in_slack<MA, LOA, HIA, MB, LOB, HIB, MC, LOC, HIC>(args, lds, ws, (M / 256) * (2 * FF / 256), G, bid, lane, wave);
    if (PROBE_DUP & 512) convert_in_slack<MA, LOA, HIA, MB, LOB, HIB, MC, LOC, HIC>(args, lds, ws, (M / 256) * (2 * FF / 256), G, bid, lane, wave);
}
__device__ __forceinline__ void resid_phase(LAS unsigned char* lds, unsigned char* ws, const bf16_t* A, const bf16_t* Bt, int K, int btile, const float* base, float* X, float alpha, int G, int bid, bool want_xb = true) {
    pg8::Gemm g{A, Bt, K, K, K, M / 256, D / 256, 1, (long)256 * K, 0, 0, 0, (long)256 * K, 0, btile, 1};
    pg8::StaticOrder S; S.init(M / 256, D / 256, 1, G, bid);
    pg8::EpiResid E{nullptr, WSP(WS_XB), (float*)(ws + WS_PART), alpha, 1.0f / alpha};
    pg8::gemm_phase<pg8::EpiResid, true>(lds, g, S, E);
}

template <int L>
__device__ __forceinline__ void layer_phases(const Args& args, LAS unsigned char* lds, unsigned char* ws, const XcdBarrier& xbar, const float* x_in, float* X, const float* p0, const float* p1, const float* p2, int lo, int hi, int coop, int G, int bid, int tid, int lane, int wave) {
    constexpr int PA = (L == 0) ? 1 : 12, P = 3 + 9 * L;
    if (IN(PA)) { if (PROBE_DUP & 2) ffn_up_phase<-1, 0, 0>(args, lds, ws, L, G, bid, lane, wave);
        if constexpr (L == 0) ffn_up_phase<4, 0, 2816, 12, 0, 2048, 13, 0, 2048>(args, lds, ws, L, G, bid, lane, wave);
        else ffn_up_phase<8, 0, 3072, 5, 0, 2816>(args, lds, ws, L, G, bid, lane, wave);
        SEAM(PA); }
    if (IN(PA + 1)) { resid_phase(lds, ws, WSP(WS_H), WSP(WS_W2T) + (size_t)L * D * FF, FF, 1, L == 0 ? x_in : X, X, 0.5f, G, bid);
        if constexpr (L != 0) SEAM(PA + 1);
    }
    if constexpr (L == 0) {
        if (IN(3)) {
            pg8::Gemm g{WSP(WS_MEMN), WSP(WS_WKVT), D, D, D, 1, 16, 2, 0, 0, (long)MEM * D, 0, (long)256 * D, (long)2 * D * D, 1, 0};
            pg8::StaticOrder S; S.init(1, 16, 2, G, bid);
            pg8::EpiBf16 E{WSP(WS_KV), 2 * D, (long)MEM * 2 * D, 1.0f, nullptr};
            pg8::gemm_phase<pg8::EpiBf16, true>(lds, g, S, E);
            if (PROBE_DUP & 128) pg8::gemm_phase<pg8::EpiBf16, true>(lds, g, S, E);
            convert_in_slack<14, 0, 1024, 15, 0, 1024, 10, 0, 2048>(args, lds, ws, 32, G, bid, lane, wave);
            if (bid >= 32 % G) wqb_convert(args, ws, (bid - 32 % G) * 512 + tid, (G - 32 % G) * 512);
            SEAM(3);
        }
        if (IN(4)) {
            { pg8::Gemm g{WSP(WS_KV), WSP(WS_WQB), 2 * D, D, HD, 4, 8, 2, (long)HD, 0, (long)MEM * 2 * D, (long)HD, (long)256 * D, (long)D * D, 0, 0};
              pg8::EpiBf16 E{WSP(WS_WQKT), D, (long)1024 * D, 0.04419417382415922f, nullptr}; pg8::StaticOrder S; S.init(4, 8, 2, G, bid);
              pg8::gemm_phase<pg8::EpiBf16, true>(lds, g, S, E); }
            { pg8::Gemm g{WSP(WS_WOT), WSP(WS_KV) + D, D, 2 * D, HD, 8, 4, 2, (long)256 * D, (long)HD, (long)D * D, 0, (long)HD, (long)MEM * 2 * D, 0, 0};
              pg8::EpiBf16 E{WSP(WS_VWOT), 1024, (long)D * 1024, 1.0f, nullptr}; pg8::StaticOrder S; S.init(8, 4, 2, G, (bid + G / 2) % G);
              pg8::gemm_phase<pg8::EpiBf16, true>(lds, g, S, E); }
            convert_in_slack<11, 0, 1024, 9, 0, 1024>(args, lds, ws, 64, G, bid, lane, wave);
            __syncthreads();
        }
    }
    if (IN(P + 2)) {
        if constexpr (L == 0) {
            pg8::Gemm g{WSP(WS_XB), WSP(WS_GWIN), D, D, D, M / 256, 16, 1, (long)256 * D, 0, 0, 0, (long)256 * D, 0, 1, 1};
            pg8::StaticOrder S; S.init(M / 256, 16, 1, G, bid);
            pg8::EpiGeluUV E{WSP(WS_U), WSP(WS_V), (const float*)(ws + WS_PART), (float*)(ws + WS_LNP)};
            pg8::gemm_phase<pg8::EpiGeluUV, true>(lds, g, S, E);
            if (PROBE_DUP & 8) pg8::gemm_phase<pg8::EpiGeluUV, true>(lds, g, S, E);
        } else {
            pg8::Gemm g{WSP(WS_XB), WSP(WS_CWIN), D, D, D, M / 256, 24, 1, (long)256 * D, 0, 0, 0, (long)256 * D, 0, 1, 1};
            pg8::StaticOrder S; S.init(M / 256, 24, 1, G, bid);
            pg8::EpiConvIn E{WSP(WS_U), WSP(WS_V), (const float*)(ws + WS_PART)};
            pg8::gemm_phase<pg8::EpiConvIn, true>(lds, g, S, E);
            if (PROBE_DUP & 8) pg8::gemm_phase<pg8::EpiConvIn, true>(lds, g, S, E);
        }
        SEAM(P + 2);
    }
    if (IN(P + 3)) {
        if constexpr (L == 0) spatial_phase(lds, ws, p0, p1, p2, G, bid, tid, lane, wave); else conv_phase(ws, p0, G, bid, tid);
        if (PROBE_DUP & 16) { if constexpr (L == 0) spatial_phase(lds, ws, p0, p1, p2, G, bid, tid, lane, wave); else conv_phase(ws, p0, G, bid, tid); }
        SEAM(P + 3);
    }
    if (IN(P + 4)) { resid_phase(lds, ws, WSP(WS_Y), L == 0 ? WSP(WS_GWOUT) : WSP(WS_CWOUT), D, 1, X, X, 1.0f, G, bid); SEAM(P + 4); }
    if (IN(P + 5)) {
        pg8::Gemm g{WSP(WS_XB), WSP(WS_WQKT) + (size_t)L * 1024 * D, D, D, D, M / 256, NH, 1, (long)256 * D, 0, 0, 0, (long)256 * D, 0, 0, 1};
        pg8::StaticOrder S; S.init(M / 256, NH, 1, G, bid);
        pg8::EpiSoftmax E{WSP(WS_P), (const float*)(ws + WS_PART)};
        pg8::gemm_phase<pg8::EpiSoftmax, false>(lds, g, S, E);
        if constexpr (L == 0) convert_in_slack<2, 0, 5632, 6, 0, 1408>(args, lds, ws, (M / 256) * NH, G, bid, lane, wave);
        else convert_in_slack<3, 0, 5632>(args, lds, ws, (M / 256) * NH, G, bid, lane, wave);
        if (PROBE_DUP & 32) pg8::gemm_phase<pg8::EpiSoftmax, false>(lds, g, S, E);
        SEAM(P + 5);
    }
    if (IN(P + 6)) { resid_phase(lds, ws, WSP(WS_P), WSP(WS_VWOT) + (size_t)L * D * 1024, 1024, 0, X, X, 1.0f, G, bid); SEAM(P + 6); }
    if (IN(P + 7)) { if (PROBE_DUP & 2) ffn_up_phase<-1, 0, 0>(args, lds, ws, 2 + L, G, bid, lane, wave);
        if constexpr (L == 0) ffn_up_phase<1, 0, 5632, 6, 1408, 2816>(args, lds, ws, 2 + L, G, bid, lane, wave);
        else ffn_up_phase<7, 0, 2816>(args, lds, ws, 2 + L, G, bid, lane, wave);
        SEAM(P + 7); }
    if (IN(P + 8)) { resid_phase(lds, ws, WSP(WS_H), WSP(WS_W2T) + (size_t)(2 + L) * D * FF, FF, 1, X, X, 0.5f, G, bid, L == 0);   SEAM(P + 8); }
}

__global__ void __launch_bounds__(512, 2) fwd_megakernel(Args args) {
    extern __shared__ __attribute__((aligned(16))) unsigned char lds_raw[];
    LAS unsigned char* lds = (LAS unsigned char*)lds_raw;
    const int tid = threadIdx.x, lane = tid & 63, wave = __builtin_amdgcn_readfirstlane(tid >> 6);
    const int G = gridDim.x, bid = blockIdx.x;
    unsigned char* ws = args.ws;
    float* X = args.out;
    const int lo = args.ph_lo, hi = args.ph_hi, coop = args.coop;
    volatile LAS unsigned* misc = (volatile LAS unsigned*)(lds + LDS_MISC);
    if (tid < 64) misc[tid] = 0u;
    __syncthreads();
    XcdBarrier xbar; xbar.bar = (unsigned*)(ws + WS_BAR); xbar.x = 0; xbar.st = nullptr;
    if (coop) xbar = xcd_barrier_post((unsigned*)(ws + WS_BAR), misc + 8);

    if (IN(0)) { for (int rep = 0; rep < 1 + (PROBE_DUP & 1); ++rep) prologue_phase(args, lds, ws, G, bid, tid, lane, wave); SEAM(0); }
    layer_phases<0>(args, lds, ws, xbar, args.in[0], X, args.in[7], args.in[8], args.in[10], lo, hi, coop, G, bid, tid, lane, wave);
    layer_phases<1>(args, lds, ws, xbar, args.in[0], X, args.in[13], nullptr, nullptr, lo, hi, coop, G, bid, tid, lane, wave);
    if ((PROBE_DUP & 256) && coop) { for (int rep = 0; rep < 40; ++rep) xcd_barrier(xbar); }
    if (IN(21)) {
        const float* __restrict__ gn = args.in[23]; const float* __restrict__ PART = (const float*)(ws + WS_PART); const bf16_t* __restrict__ XBF = WSP(WS_XB); float* __restrict__ Xo = X;
        const int gw = bid * 8 + wave, NGW = G * 8;
#pragma unroll 2
        for (int m = gw; m < M; m += NGW) {
            u32x4 w[4];
#pragma unroll
            for (int j = 0; j < 4; ++j) w[j] = *(const u32x4*)(XBF + tm_off(m, 512 * j + 8 * lane, D));
            float s = PART[(size_t)m * 32 + (lane & 31)];
            s += __shfl_xor(s, 1); s += __shfl_xor(s, 2); s += __shfl_xor(s, 4); s += __shfl_xor(s, 8); s += __shfl_xor(s, 16);
            const float rs = 1.0f / sqrtf(s * (1.0f / D) + RMS_EPS);
            float* orow = Xo + (size_t)m * D;
#pragma unroll
            for (int j = 0; j < 4; ++j) { const int c = 512 * j + 8 * lane;
                const f32x4 lo = (f32x4){__uint_as_float(w[j].x << 16), __uint_as_float(w[j].x & 0xffff0000u), __uint_as_float(w[j].y << 16), __uint_as_float(w[j].y & 0xffff0000u)};
                const f32x4 hi = (f32x4){__uint_as_float(w[j].z << 16), __uint_as_float(w[j].z & 0xffff0000u), __uint_as_float(w[j].w << 16), __uint_as_float(w[j].w & 0xffff0000u)};
                *(f32x4*)(orow + c) = lo * rs * *(const f32x4*)(gn + c); *(f32x4*)(orow + c + 4) = hi * rs * *(const f32x4*)(gn + c + 4); }
        }
    }
}

extern "C" void kernel_launch(void* const* d_in, const int* in_sizes, int n_in, void* d_out, int out_size, void* d_ws, size_t ws_size, hipStream_t stream) {
    static int grid = 0;
    if (grid == 0) {
        if (n_in != 24 || out_size != M * D || ws_size < WS_END) { fprintf(stderr, "kernel_launch: unexpected shapes: n_in %d out %d ws %zu (need %zu)\n", n_in, out_size, ws_size, (size_t)WS_END); grid = -1; return; }
        int dev = 0, cus = 0, per_cu = 0;
        hipGetDevice(&dev); hipDeviceGetAttribute(&cus, hipDeviceAttributeMultiprocessorCount, dev);
        if (hipFuncSetAttribute((const void*)fwd_megakernel, hipFuncAttributeMaxDynamicSharedMemorySize, LDS_BYTES) != hipSuccess) { fprintf(stderr, "kernel_launch: hipFuncSetAttribute failed\n"); grid = -1; return; }
        if (hipOccupancyMaxActiveBlocksPerMultiprocessor(&per_cu, (const void*)fwd_megakernel, 512, LDS_BYTES) != hipSuccess || per_cu < 1) { fprintf(stderr, "kernel_launch: occupancy query failed (%d)\n", per_cu); per_cu = 1; }
        (void)hipGetLastError();
        grid = cus * per_cu;
        fprintf(stderr, "kernel_launch: grid %d (cus %d x %d)\n", grid, cus, per_cu);
    }
    if (grid < 0) return;
    Args a{};
    for (int i = 0; i < 24; ++i) a.in[i] = (const float*)d_in[i];
    a.out = (float*)d_out; a.ws = (unsigned char*)d_ws;
#if MK_PER_PHASE
    for (int ph = 0; ph < NPHASE; ++ph) { a.ph_lo = ph; a.ph_hi = ph + 1; a.coop = 0;
        hipLaunchKernelGGL(fwd_megakernel, dim3(grid), dim3(512), LDS_BYTES, stream, a); }
#else
    a.ph_lo = 0; a.ph_hi = NPHASE; a.coop = 1;
    if (hipMemsetAsync((char*)d_ws + WS_BAR, 0, 16384, stream) != hipSuccess) { fprintf(stderr, "kernel_launch: memset of barrier words failed\n"); return; }
    void* kargs[] = {&a};
    hipError_t e = hipLaunchCooperativeKernel((const void*)fwd_megakernel, dim3(grid), dim3(512), kargs, LDS_BYTES, stream);
    if (e != hipSuccess) fprintf(stderr, "kernel_launch: cooperative launch failed: %s (grid %d)\n", hipGetErrorString(e), grid);
#endif
}
```
